# Optimizing an MI355X kernel written in HIP

```python
import jax, jax.numpy as jnp
from jax import lax
import numpy as np

D_MODEL = 1024
BATCH = 16
SEQ = 4096
DEPTH = 1

CTX_LEN = 256
GRID_W = 64
HEAD_DIM = 64
ATTN_WIDTH = D_MODEL // 2
N_Q_HEADS = ATTN_WIDTH // HEAD_DIM
N_KV_HEADS = 2
Q_PER_KV = N_Q_HEADS // N_KV_HEADS
KV_WIDTH = N_KV_HEADS * HEAD_DIM
WINDOW = 128
BLOCK = 128
ROPE_BASE = 10000.0
LRU_WIDTH = D_MODEL - ATTN_WIDTH
LRU_BLOCKS = 8
LRU_BLOCK_DIM = LRU_WIDTH // LRU_BLOCKS
CONV_WIDTH = 4
LRU_C = 8.0
MIX_WIDTH = ATTN_WIDTH + LRU_WIDTH
IN_SPLITS = (ATTN_WIDTH, ATTN_WIDTH + KV_WIDTH, ATTN_WIDTH + 2 * KV_WIDTH,
             ATTN_WIDTH + 2 * KV_WIDTH + LRU_WIDTH)
IN_WIDTH = ATTN_WIDTH + 2 * KV_WIDTH + 2 * LRU_WIDTH
N_EXPERTS = 16
CAPACITY_FACTOR = 2
D_EXPERT = D_MODEL
EPS = 1e-6
NEG_INF = -1e30

kernel_name = "hybrid_attn_rglru_ec_moe_dit_layer"


def rmsnorm(x, g):
    xf = x.astype(jnp.float32)
    xf = xf * lax.rsqrt(jnp.mean(xf * xf, axis=-1, keepdims=True) + EPS)
    return (xf * g.astype(jnp.float32)).astype(x.dtype)


def modulate(h, shift, scale):
    return h * (1 + scale) + shift


def ada_params(cond, w_ada, b_ada):
    m = jax.nn.silu(cond) @ w_ada + b_ada
    return jnp.split(m[..., None, :], 6, axis=-1)


def rope_2d_tables(rows):
    row = jnp.broadcast_to(jnp.arange(rows)[:, None], (rows, GRID_W)).reshape(-1).astype(jnp.float32)
    col = jnp.broadcast_to(jnp.arange(GRID_W)[None, :], (rows, GRID_W)).reshape(-1).astype(jnp.float32)
    n_freq = HEAD_DIM // 4
    inv_freq = ROPE_BASE ** (-jnp.arange(n_freq, dtype=jnp.float32) / n_freq)
    ang = jnp.stack([row[:, None] * inv_freq, col[:, None] * inv_freq], axis=1)
    return jnp.cos(ang), jnp.sin(ang)


def apply_rope_2d(x, cos, sin):
    xs = x.astype(jnp.float32).reshape(x.shape[:-1] + (2, 2, HEAD_DIM // 4))
    x1, x2 = xs[..., 0, :], xs[..., 1, :]
    cs, sn = cos[None, :, None], sin[None, :, None]
    out = jnp.stack([x1 * cs - x2 * sn, x2 * cs + x1 * sn], axis=-2)
    return out.reshape(x.shape).astype(x.dtype)


def windowed_attention_with_context(q, k, v, k_c, v_c, sink):
    bsz, n = q.shape[0], q.shape[1]
    n_ctx = k_c.shape[1]
    nb = n // BLOCK
    scale = HEAD_DIM ** -0.5
    qb = q.reshape(bsz, nb, BLOCK, N_KV_HEADS, Q_PER_KV, HEAD_DIM).transpose(1, 0, 3, 4, 2, 5)
    pad = ((0, 0), (BLOCK, BLOCK), (0, 0), (0, 0))
    k_pad = jnp.pad(k, pad).transpose(0, 2, 1, 3)
    v_pad = jnp.pad(v, pad).transpose(0, 2, 1, 3)
    kc = k_c.transpose(0, 2, 1, 3)
    vc = v_c.transpose(0, 2, 1, 3)
    sink_l = sink.astype(jnp.float32).reshape(N_KV_HEADS, Q_PER_KV)[None, :, :, None, None]
    offs_q = jnp.arange(BLOCK)
    offs_k = jnp.arange(3 * BLOCK) - BLOCK

    def one_block(args):
        i, q_i = args
        start = i * BLOCK
        k_i = lax.dynamic_slice_in_dim(k_pad, start, 3 * BLOCK, axis=2)
        v_i = lax.dynamic_slice_in_dim(v_pad, start, 3 * BLOCK, axis=2)
        q_pos = start + offs_q
        k_pos = start + offs_k
        valid = ((jnp.abs(q_pos[:, None] - k_pos[None, :]) <= WINDOW)
                 & (k_pos >= 0)[None, :] & (k_pos < n)[None, :])
        s_loc = jnp.einsum('bhgqd,bhkd->bhgqk', q_i, k_i).astype(jnp.float32) * scale
        s_loc = jnp.where(valid, s_loc, NEG_INF)
        s_ctx = jnp.einsum('bhgqd,bhkd->bhgqk', q_i, kc).astype(jnp.float32) * scale
        sink_b = jnp.broadcast_to(sink_l, s_ctx.shape[:-1] + (1,))
        p = jax.nn.softmax(jnp.concatenate([s_loc, s_ctx, sink_b], axis=-1), axis=-1)
        p_loc = p[..., :3 * BLOCK].astype(v.dtype)
        p_ctx = p[..., 3 * BLOCK:3 * BLOCK + n_ctx].astype(v.dtype)
        return (jnp.einsum('bhgqk,bhkd->bhgqd', p_loc, v_i)
                + jnp.einsum('bhgqk,bhkd->bhgqd', p_ctx, vc))

    out = lax.map(one_block, (jnp.arange(nb), qb))
    return out.transpose(1, 0, 4, 2, 3, 5).reshape(bsz, n, N_Q_HEADS * HEAD_DIM)


def context_attention(q_c, k_c, v_c, sink):
    bsz, n_ctx = q_c.shape[0], q_c.shape[1]
    qg = q_c.reshape(bsz, n_ctx, N_KV_HEADS, Q_PER_KV, HEAD_DIM)
    s = jnp.einsum('bqhgd,bkhd->bhgqk', qg, k_c).astype(jnp.float32) * (HEAD_DIM ** -0.5)
    sink_b = jnp.broadcast_to(sink.astype(jnp.float32).reshape(N_KV_HEADS, Q_PER_KV)[None, :, :, None, None],
                              s.shape[:-1] + (1,))
    p = jax.nn.softmax(jnp.concatenate([s, sink_b], axis=-1), axis=-1)[..., :n_ctx].astype(v_c.dtype)
    o = jnp.einsum('bhgqk,bkhd->bqhgd', p, v_c)
    return o.reshape(bsz, n_ctx, N_Q_HEADS * HEAD_DIM)


def centred_depthwise_conv(x, w, b):
    n = x.shape[1]
    left = CONV_WIDTH // 2
    right = CONV_WIDTH - 1 - left
    xp = jnp.pad(x, ((0, 0), (left, right), (0, 0)))
    y = b + w[0] * xp[:, 0:n]
    for j in range(1, CONV_WIDTH):
        y = y + w[j] * xp[:, j:j + n]
    return y


def block_diag_linear(x, w, b):
    xb = x.reshape(x.shape[:-1] + (LRU_BLOCKS, LRU_BLOCK_DIM))
    return jnp.einsum('blnd,nde->blne', xb, w).reshape(x.shape) + b


def lru_coeffs(xc, w_r, b_r, w_i, b_i, lam):
    r = jax.nn.sigmoid(block_diag_linear(xc, w_r, b_r).astype(jnp.float32))
    i = jax.nn.sigmoid(block_diag_linear(xc, w_i, b_i).astype(jnp.float32))
    log_a = -LRU_C * r * jax.nn.softplus(-lam.astype(jnp.float32))
    a = jnp.exp(log_a)
    mult = jnp.sqrt(-jnp.expm1(2.0 * log_a))
    return a, mult * i * xc.astype(jnp.float32)


def _combine(left, right):
    a_l, b_l = left
    a_r, b_r = right
    return a_l * a_r, a_r * b_l + b_r


def linear_scan(a, b, h0, reverse):
    if reverse:
        a, b = jnp.flip(a, axis=1), jnp.flip(b, axis=1)
    a_cum, h = lax.associative_scan(_combine, (a, b), axis=1)
    h = h + a_cum * h0[:, None, :]
    if reverse:
        h = jnp.flip(h, axis=1)
    return h


def bidirectional_rglru(xr_lat, xr_ctx, conv_w, conv_b, w_r, b_r, w_i, b_i, lam):
    xc_lat = centred_depthwise_conv(xr_lat, conv_w, conv_b)
    xc_ctx = centred_depthwise_conv(xr_ctx, conv_w, conv_b)
    h_lat_sum, h_ctx_sum = None, None
    for d in range(2):
        reverse = d == 1
        a_c, b_c = lru_coeffs(xc_ctx, w_r[d], b_r[d], w_i[d], b_i[d], lam[d])
        h_c = linear_scan(a_c, b_c, jnp.zeros_like(a_c[:, 0]), reverse)
        h0 = h_c[:, 0] if reverse else h_c[:, -1]
        a_l, b_l = lru_coeffs(xc_lat, w_r[d], b_r[d], w_i[d], b_i[d], lam[d])
        h_l = linear_scan(a_l, b_l, h0, reverse)
        h_lat_sum = h_l if h_lat_sum is None else h_lat_sum + h_l
        h_ctx_sum = h_c if h_ctx_sum is None else h_ctx_sum + h_c
    return h_lat_sum.astype(xr_lat.dtype), h_ctx_sum.astype(xr_ctx.dtype)


def expert_choice_moe(h, w_router, w_gate, w_up, w_down):
    bsz, n, dm = h.shape
    cap = CAPACITY_FACTOR * n // N_EXPERTS
    affinity = jax.nn.softmax((h @ w_router).astype(jnp.float32), axis=-1)
    gate_vals, idx = lax.top_k(affinity.transpose(0, 2, 1), cap)
    idx_flat = idx.reshape(bsz, N_EXPERTS * cap)
    xs = jnp.take_along_axis(h, idx_flat[..., None], axis=1).reshape(bsz, N_EXPERTS, cap, dm)
    hid = (jax.nn.silu(jnp.einsum('becd,edf->becf', xs, w_gate))
           * jnp.einsum('becd,edf->becf', xs, w_up))
    ys = jnp.einsum('becf,efd->becd', hid, w_down) * gate_vals[..., None].astype(h.dtype)
    out = jnp.zeros_like(h).at[jnp.arange(bsz)[:, None], idx_flat].add(
        ys.reshape(bsz, N_EXPERTS * cap, dm))
    return out


def setup_inputs(seed: int = 0) -> dict:
    key = jax.random.key(seed)
    ks = jax.random.split(key, 24)
    f32 = jnp.float32
    nrm = lambda k, shape, s: jax.random.normal(k, shape, f32) * s
    u = jax.random.uniform(ks[16], (DEPTH, 2, LRU_WIDTH), f32, 0.9, 0.999)
    a0 = u ** (1.0 / LRU_C)
    lru_lambda = jnp.log(a0) - jnp.log1p(-a0)
    return {
        "x": nrm(ks[0], (BATCH, SEQ, D_MODEL), 1.0),
        "c": nrm(ks[1], (BATCH, D_MODEL), 1.0),
        "ctx": nrm(ks[2], (BATCH, CTX_LEN, D_MODEL), 1.0),
        "c_ctx": nrm(ks[3], (D_MODEL,), 1.0),
        "w_ada": nrm(ks[4], (DEPTH, D_MODEL, 6 * D_MODEL), 0.5 * D_MODEL ** -0.5),
        "b_ada": nrm(ks[5], (DEPTH, 6 * D_MODEL), 0.02),
        "norm1_g": 1.0 + nrm(ks[6], (DEPTH, D_MODEL), 0.05),
        "norm2_g": 1.0 + nrm(ks[7], (DEPTH, D_MODEL), 0.05),
        "w_in": nrm(ks[8], (DEPTH, D_MODEL, IN_WIDTH), D_MODEL ** -0.5),
        "q_norm_g": 1.0 + nrm(ks[9], (DEPTH, HEAD_DIM), 0.05),
        "k_norm_g": 1.0 + nrm(ks[10], (DEPTH, HEAD_DIM), 0.05),
        "attn_sink": nrm(ks[11], (DEPTH, N_Q_HEADS), 0.5),
        "conv_w": nrm(ks[12], (DEPTH, CONV_WIDTH, LRU_WIDTH), CONV_WIDTH ** -0.5),
        "conv_b": nrm(ks[13], (DEPTH, LRU_WIDTH), 0.02),
        "lru_w_r": nrm(ks[14], (DEPTH, 2, LRU_BLOCKS, LRU_BLOCK_DIM, LRU_BLOCK_DIM), LRU_BLOCK_DIM ** -0.5),
        "lru_b_r": nrm(ks[15], (DEPTH, 2, LRU_WIDTH), 0.02),
        "lru_w_i": nrm(ks[17], (DEPTH, 2, LRU_BLOCKS, LRU_BLOCK_DIM, LRU_BLOCK_DIM), LRU_BLOCK_DIM ** -0.5),
        "lru_b_i": nrm(ks[18], (DEPTH, 2, LRU_WIDTH), 0.02),
        "lru_lambda": lru_lambda,
        "w_out": nrm(ks[19], (DEPTH, MIX_WIDTH, D_MODEL), MIX_WIDTH ** -0.5),
        "w_router": nrm(ks[20], (DEPTH, D_MODEL, N_EXPERTS), D_MODEL ** -0.5),
        "w_gate": nrm(ks[21], (DEPTH, N_EXPERTS, D_MODEL, D_EXPERT), D_MODEL ** -0.5),
        "w_up": nrm(ks[22], (DEPTH, N_EXPERTS, D_MODEL, D_EXPERT), D_MODEL ** -0.5),
        "w_down": nrm(ks[23], (DEPTH, N_EXPERTS, D_EXPERT, D_MODEL), D_EXPERT ** -0.5),
    }


def reference(x, c, ctx, c_ctx, w_ada, b_ada, norm1_g, norm2_g, w_in, q_norm_g, k_norm_g,
              attn_sink, conv_w, conv_b, lru_w_r, lru_b_r, lru_w_i, lru_b_i, lru_lambda,
              w_out, w_router, w_gate, w_up, w_down):
    bsz, n, _ = x.shape
    n_ctx = ctx.shape[1]
    rows = n // GRID_W
    cos, sin = rope_2d_tables(rows)
    for layer in range(DEPTH):
        sh1, sc1, g1, sh2, sc2, g2 = ada_params(c, w_ada[layer], b_ada[layer])
        csh1, csc1, cg1, csh2, csc2, cg2 = ada_params(c_ctx, w_ada[layer], b_ada[layer])

        h = modulate(rmsnorm(x, norm1_g[layer]), sh1, sc1)
        hc = modulate(rmsnorm(ctx, norm1_g[layer]), csh1, csc1)
        q, k, v, xr, gr = jnp.split(h @ w_in[layer], IN_SPLITS, axis=-1)
        q_c, k_c, v_c, xr_c, gr_c = jnp.split(hc @ w_in[layer], IN_SPLITS, axis=-1)

        q = apply_rope_2d(rmsnorm(q.reshape(bsz, n, N_Q_HEADS, HEAD_DIM), q_norm_g[layer]), cos, sin)
        k = apply_rope_2d(rmsnorm(k.reshape(bsz, n, N_KV_HEADS, HEAD_DIM), k_norm_g[layer]), cos, sin)
        v = v.reshape(bsz, n, N_KV_HEADS, HEAD_DIM)
        q_c = rmsnorm(q_c.reshape(bsz, n_ctx, N_Q_HEADS, HEAD_DIM), q_norm_g[layer])
        k_c = rmsnorm(k_c.reshape(bsz, n_ctx, N_KV_HEADS, HEAD_DIM), k_norm_g[layer])
        v_c = v_c.reshape(bsz, n_ctx, N_KV_HEADS, HEAD_DIM)

        attn_lat = windowed_attention_with_context(q, k, v, k_c, v_c, attn_sink[layer])
        rnn_lat, rnn_ctx = bidirectional_rglru(xr, xr_c, conv_w[layer], conv_b[layer],
                                               lru_w_r[layer], lru_b_r[layer], lru_w_i[layer],
                                               lru_b_i[layer], lru_lambda[layer])
        y = jnp.concatenate([attn_lat, rnn_lat * jax.nn.gelu(gr)], axis=-1) @ w_out[layer]
        x = x + g1 * y

        h2 = modulate(rmsnorm(x, norm2_g[layer]), sh2, sc2)
        x = x + g2 * expert_choice_moe(h2, w_router[layer], w_gate[layer], w_up[layer], w_down[layer])

        if layer + 1 < DEPTH:
            attn_ctx = context_attention(q_c, k_c, v_c, attn_sink[layer])
            yc = jnp.concatenate([attn_ctx, rnn_ctx * jax.nn.gelu(gr_c)], axis=-1) @ w_out[layer]
            ctx = ctx + cg1 * yc
            hc2 = modulate(rmsnorm(ctx, norm2_g[layer]), csh2, csc2)
            ctx = ctx + cg2 * expert_choice_moe(hc2, w_router[layer], w_gate[layer], w_up[layer], w_down[layer])
    return x
```

```cpp
#include <hip/hip_runtime.h>
#include <hip/hip_cooperative_groups.h>
#include <cstdio>
#include <cstdint>
namespace cg = cooperative_groups;

#define LAS __attribute__((address_space(3)))
typedef unsigned short bf16_t;
typedef short bf16x8 __attribute__((ext_vector_type(8)));
typedef short s16x4 __attribute__((ext_vector_type(4)));
typedef float f32x4 __attribute__((ext_vector_type(4)));
typedef float f32x16 __attribute__((ext_vector_type(16)));
typedef unsigned u32x4 __attribute__((ext_vector_type(4)));
typedef unsigned u32x2 __attribute__((ext_vector_type(2)));

constexpr int NB = 16, SEQL = 4096, DM = 1024, LCTX = 256, NIN = 1792;
constexpr int ML = NB * SEQL, MC = NB * LCTX, MT = ML + MC;
constexpr int NE = 16, CAP = 512, MX = NB * NE * CAP;
constexpr int NTHREADS = 512, NWAVES = 8;
constexpr float EPSN = 1e-6f;
constexpr float LOG2E = 1.4426950408889634f;

constexpr size_t MiB = 1u << 20;
constexpr size_t WS_CTL = 0, WS_MOD = 1 * MiB, WS_WIN = 2 * MiB, WS_WOUT = 6 * MiB, WS_WUP = 8 * MiB, WS_WDN = 72 * MiB, WS_AFF = 104 * MiB,
                 WS_IDX = 108 * MiB, WS_GV = 109 * MiB, WS_H = 110 * MiB, WS_QKV = 246 * MiB, WS_AO = 484 * MiB, WS_XS = 612 * MiB, WS_HF = 868 * MiB,
                 WS_SLOT = 996 * MiB, WS_END = 1000 * MiB;
constexpr size_t WS_HID = WS_QKV;
constexpr size_t WS_YS = WS_XS;
constexpr size_t WS_AGG = WS_HF;
constexpr size_t WS_LW = WS_MOD + 512 * 1024;
constexpr int LDS_BYTES = 147456;

__device__ __forceinline__ unsigned f2bf(float f) { unsigned u = __builtin_bit_cast(unsigned, f); return (u + 0x7fffu + ((u >> 16) & 1u)) >> 16; }
__device__ __forceinline__ unsigned pk2(float lo, float hi) { unsigned r; asm("v_cvt_pk_bf16_f32 %0, %1, %2" : "=v"(r) : "v"(lo), "v"(hi)); return r; }
__device__ __forceinline__ float bflo(unsigned u) { return __builtin_bit_cast(float, u << 16); }
__device__ __forceinline__ float bfhi(unsigned u) { return __builtin_bit_cast(float, u & 0xffff0000u); }
__device__ __forceinline__ float bf1(bf16_t h) { return __builtin_bit_cast(float, ((unsigned)h) << 16); }
__device__ __forceinline__ void unpack8(u32x4 r, float* o) { o[0] = bflo(r.x); o[1] = bfhi(r.x); o[2] = bflo(r.y); o[3] = bfhi(r.y); o[4] = bflo(r.z); o[5] = bfhi(r.z); o[6] = bflo(r.w); o[7] = bfhi(r.w); }
__device__ __forceinline__ bf16x8 pack8(const float* v) { u32x4 w; w.x = pk2(v[0], v[1]); w.y = pk2(v[2], v[3]); w.z = pk2(v[4], v[5]); w.w = pk2(v[6], v[7]); return __builtin_bit_cast(bf16x8, w); }
__device__ __forceinline__ float wave_sum(float v) {
#pragma unroll
    for (int o = 1; o < 64; o <<= 1) v += __shfl_xor(v, o);
    return v;
}
__device__ __forceinline__ int crow(int r, int hi) { return (r & 3) + 8 * (r >> 2) + 4 * hi; }
__device__ __forceinline__ float sigmoidf_(float x) { return 1.0f / (1.0f + __expf(-x)); }

namespace pg8 {
#define PG8_LAS __attribute__((address_space(3)))
constexpr int BM = 256, BK = 64, HALF = 128, HTB = HALF * BK * 2, STAGE_BYTES = 8 * HTB, NXCD = 8, WGM = 8;
__host__ __device__ __forceinline__ int lds_byte(int r, int c) { const int st = (r >> 4) * 2 + (c >> 5), rr = r & 15, cc = c & 31, ob = rr * 64 + cc * 2; return st * 1024 + (ob ^ (((ob >> 9) & 1) << 5)); }
__host__ __device__ __forceinline__ void stage_rc(int b, int& R, int& C) { const int st = b / 1024, sb = b % 1024, swz = sb ^ (((sb >> 9) & 1) << 5); R = (st >> 1) * 16 + swz / 64; C = (st & 1) * 32 + (swz % 64) / 2; }
__host__ __device__ __forceinline__ int perm32(int rho) { const int n = rho >> 4, i = rho & 15; return 8 * (i >> 2) + 4 * n + (i & 3); }

struct Unit { int pm, pn, e; };
struct Gemm { const bf16_t* A; const bf16_t* Bt; int M, N, K; const int* rowmap; };

struct Order {
    int nM, nN, nwg, G, c, mode; size_t bstride;
    __device__ void init(int M, int N, int G_, int c_, int mode_, size_t bstride_) { nM = M / BM; nN = N / BM; nwg = nM * nN; G = G_; c = c_; mode = mode_; bstride = bstride_; }
    __device__ bool next(int i, Unit& u) const {
        const long Lq = (long)i * G + c; if (Lq >= nwg) return false;
        int wgid = (int)Lq; { const int q = nwg / NXCD, r = nwg % NXCD, xcd = wgid % NXCD, off = wgid / NXCD; wgid = (xcd < r ? xcd * (q + 1) : r * (q + 1) + (xcd - r) * q) + off; }
        const int nig = WGM * nN, gid = wgid / nig, fm = gid * WGM, gsz = (nM - fm) < WGM ? (nM - fm) : WGM;
        int pm = fm + ((wgid % nig) % gsz); u.pn = (wgid % nig) / gsz; u.e = 0;
        if (mode == 1) { const int e = pm >> 5, b = (pm >> 1) & 15, hf = pm & 1; pm = (b * 16 + e) * 2 + hf; u.e = e; }
        u.pm = pm; return true;
    }
};

__device__ __forceinline__ unsigned cvt_pk_bf16(float lo, float hi) { unsigned r; asm volatile("v_cvt_pk_bf16_f32 %0, %1, %2" : "=v"(r) : "v"(lo), "v"(hi)); return r; }

struct EpiStoreBf16 {
    static constexpr bool PERM = true;
    bf16_t* O; int ldc; const float* rs;
    __device__ __forceinline__ void operator()(const f32x4 (&acc)[2][2][4][2], const Unit& u, int wr, int wc, int fr, int fq) const {
        const int row0 = u.pm * BM + wr * 64 + fr, col0 = u.pn * BM + wc * 32 + 8 * fq;
#pragma unroll
        for (int ai = 0; ai < 2; ++ai)
#pragma unroll
            for (int m = 0; m < 4; ++m) { const int r = row0 + ai * HALF + m * 16; const float s = rs ? rs[r] : 1.0f; bf16_t* rowp = O + (size_t)r * ldc + col0;
#pragma unroll
                for (int bj = 0; bj < 2; ++bj) { const f32x4 v0 = acc[ai][bj][m][0] * s, v1 = acc[ai][bj][m][1] * s;
                    u32x4 w; w.x = cvt_pk_bf16(v0[0], v0[1]); w.y = cvt_pk_bf16(v0[2], v0[3]); w.z = cvt_pk_bf16(v1[0], v1[1]); w.w = cvt_pk_bf16(v1[2], v1[3]);
                    *(u32x4*)(rowp + bj * HALF) = w; } }
    }
};
struct EpiResid {
    static constexpr bool PERM = false;
    const float* x; float* out; const float* gate;
    __device__ __forceinline__ void operator()(const f32x4 (&acc)[2][2][4][2], const Unit& u, int wr, int wc, int fr, int fq) const {
        const int row0 = u.pm * BM + wr * 64 + fr, col0 = u.pn * BM + wc * 32 + 4 * fq; const int b = u.pm >> 4;
        f32x4 gv[2][2];
#pragma unroll
        for (int bj = 0; bj < 2; ++bj)
#pragma unroll
            for (int n = 0; n < 2; ++n) gv[bj][n] = *(const f32x4*)(gate + (size_t)b * 6144 + col0 + bj * HALF + n * 16);
#pragma unroll
        for (int ai = 0; ai < 2; ++ai) {
            f32x4 xv[4][2][2];
#pragma unroll
            for (int m = 0; m < 4; ++m) { const size_t ro = (size_t)(row0 + ai * HALF + m * 16) * DM + col0;
#pragma unroll
                for (int bj = 0; bj < 2; ++bj)
#pragma unroll
                    for (int n = 0; n < 2; ++n) xv[m][bj][n] = *(const f32x4*)(x + ro + bj * HALF + n * 16); }
            __builtin_amdgcn_sched_barrier(0);
#pragma unroll
            for (int m = 0; m < 4; ++m) { const size_t ro = (size_t)(row0 + ai * HALF + m * 16) * DM + col0;
#pragma unroll
                for (int bj = 0; bj < 2; ++bj)
#pragma unroll
                    for (int n = 0; n < 2; ++n) *(f32x4*)(out + ro + bj * HALF + n * 16) = xv[m][bj][n] + gv[bj][n] * acc[ai][bj][m][n]; }
            __builtin_amdgcn_sched_barrier(0);
        }
    }
};
struct EpiSwiGLU {
    static constexpr bool PERM = true;
    bf16_t* O;
    __device__ __forceinline__ void operator()(const f32x4 (&acc)[2][2][4][2], const Unit& u, int wr, int wc, int fr, int fq) const {
        const int row0 = u.pm * BM + wr * 64 + fr, col0 = u.pn * HALF + wc * 32 + 8 * fq;
#pragma unroll
        for (int ai = 0; ai < 2; ++ai)
#pragma unroll
            for (int m = 0; m < 4; ++m) { bf16_t* rowp = O + (size_t)(row0 + ai * HALF + m * 16) * DM + col0; float h[8];
#pragma unroll
                for (int n = 0; n < 2; ++n)
#pragma unroll
                    for (int j = 0; j < 4; ++j) { const float g = acc[ai][0][m][n][j], up = acc[ai][1][m][n][j]; h[n * 4 + j] = g * __builtin_amdgcn_rcpf(1.0f + __expf(-g)) * up; }
                u32x4 w; w.x = cvt_pk_bf16(h[0], h[1]); w.y = cvt_pk_bf16(h[2], h[3]); w.z = cvt_pk_bf16(h[4], h[5]); w.w = cvt_pk_bf16(h[6], h[7]);
                *(u32x4*)rowp = w; }
    }
};

template <class Epi, bool ALIGN_EPI = true, bool GATHER = false>
__device__ __forceinline__ void gemm_phase(PG8_LAS unsigned char* lds, const Gemm g, const Order& S, const Epi& E) {
    const int tid = threadIdx.x, wid = __builtin_amdgcn_readfirstlane(tid >> 6), lane = tid & 63, wr = wid >> 2, wc = wid & 3, fr = lane & 15, fq = lane >> 4;
    const int K = g.K, nt = K / BK;
    unsigned voffA[2], voffB[2]; int Rr[2], Cc[2];
#pragma unroll
    for (int i = 0; i < 2; ++i) { int R, C; stage_rc(tid * 16 + i * 8192, R, C); const int Rb = Epi::PERM ? ((R & ~31) + perm32(R & 31)) : R; Rr[i] = R; Cc[i] = C;
        voffA[i] = (unsigned)(R * K + C) * 2u; voffB[i] = (unsigned)(Rb * K + C) * 2u; }
    unsigned offC[2][2], offN[2][2];
#define PG8_LOAD_OFF(dst, U) do { _Pragma("unroll") for (int _h = 0; _h < 2; ++_h) _Pragma("unroll") for (int _i = 0; _i < 2; ++_i) \
        dst[_h][_i] = (unsigned)g.rowmap[(size_t)(U).pm * BM + _h * HALF + Rr[_i]] * (unsigned)(K * 2) + (unsigned)Cc[_i] * 2u; } while (0)
#define PG8_STAGE_A(bufoff, kptr, H, NXT) do { _Pragma("unroll") for (int _i = 0; _i < 2; ++_i) { \
        const char* _p = GATHER ? ((const char*)(kptr) + ((NXT) ? offN[H][_i] : offC[H][_i])) : ((const char*)(kptr) + (size_t)(H) * hstep + voffA[_i]); \
        __builtin_amdgcn_global_load_lds((const unsigned*)_p, (PG8_LAS unsigned*)(lds + (bufoff) + ldsw + _i * 8192), 16, 0, 0); } } while (0)
    const size_t kstep = (size_t)(BK * 2);
    const size_t hstep = (size_t)HALF * K * 2;
    const size_t tstep = 2 * hstep;
    const unsigned ldsw = (unsigned)wid * 1024u;
    const int aoff = lds_byte(wr * 64 + fr, fq * 8), boff = lds_byte(wc * 32 + fr, fq * 8);
#define PG8_SA(b, h) (((b) * 2 + (h)) * HTB)
#define PG8_SB(b, h) ((4 + (b) * 2 + (h)) * HTB)
#define PG8_STAGE(bufoff, gbase, voff) do { _Pragma("unroll") for (int _i = 0; _i < 2; ++_i) \
        __builtin_amdgcn_global_load_lds((const unsigned*)((const char*)(gbase) + (voff)[_i]), (PG8_LAS unsigned*)(lds + (bufoff) + ldsw + _i * 8192), 16, 0, 0); } while (0)
#define PG8_LDA(dst, b, h) do { _Pragma("unroll") for (int m = 0; m < 4; ++m) _Pragma("unroll") for (int k = 0; k < 2; ++k) dst[m][k] = *(const PG8_LAS bf16x8*)(lds + PG8_SA(b, h) + aoff + m * 2048 + k * 1024); } while (0)
#define PG8_LDB(dst, b, h) do { _Pragma("unroll") for (int n = 0; n < 2; ++n) _Pragma("unroll") for (int k = 0; k < 2; ++k) dst[n][k] = *(const PG8_LAS bf16x8*)(lds + PG8_SB(b, h) + boff + n * 2048 + k * 1024); } while (0)
#define PG8_MMA(ai, bj, At, Bt) do { __builtin_amdgcn_s_setprio(1); _Pragma("unroll") for (int m = 0; m < 4; ++m) _Pragma("unroll") for (int n = 0; n < 2; ++n) _Pragma("unroll") for (int k = 0; k < 2; ++k) \
        acc[ai][bj][m][n] = __builtin_amdgcn_mfma_f32_16x16x32_bf16(Bt[n][k], At[m][k], acc[ai][bj][m][n], 0, 0, 0); __builtin_amdgcn_s_setprio(0); } while (0)
#define PG8_WAIT_V(n) asm volatile("s_waitcnt vmcnt(" #n ")" ::: "memory")
#define PG8_WAIT_L(n) asm volatile("s_waitcnt lgkmcnt(" #n ")" ::: "memory")
#define PG8_BAR __builtin_amdgcn_s_barrier()
#define PG8_SCHED __builtin_amdgcn_sched_barrier(0)
    Unit cur, nxt; int ui = 0;
    if (!S.next(0, cur)) return;
    f32x4 acc[2][2][4][2];
#pragma unroll
    for (int a = 0; a < 2; ++a)
#pragma unroll
        for (int b = 0; b < 2; ++b)
#pragma unroll
            for (int m = 0; m < 4; ++m)
#pragma unroll
                for (int n = 0; n < 2; ++n) acc[a][b][m][n] = (f32x4){0.f, 0.f, 0.f, 0.f};
    bf16x8 At[4][2], B0[2][2], B1[2][2];
    const char* cA = GATHER ? (const char*)g.A : (const char*)g.A + (size_t)cur.pm * tstep; const char* cB = (const char*)g.Bt + (size_t)cur.e * S.bstride + (size_t)cur.pn * tstep;
    if constexpr (GATHER) { PG8_LOAD_OFF(offC, cur); }
    PG8_STAGE(PG8_SB(0, 0), cB, voffB); PG8_STAGE(PG8_SB(0, 1), cB + hstep, voffB); PG8_STAGE_A(PG8_SA(0, 0), cA, 0, false); PG8_STAGE_A(PG8_SA(0, 1), cA, 1, false);
    if (wr == 1) PG8_BAR;
    PG8_WAIT_V(2); PG8_BAR;
    PG8_STAGE(PG8_SB(1, 0), cB + kstep, voffB); PG8_STAGE_A(PG8_SA(1, 0), cA + kstep, 0, false); PG8_STAGE(PG8_SB(1, 1), cB + hstep + kstep, voffB);
    PG8_WAIT_V(6); PG8_BAR;
    for (;;) {
        const bool has_next = S.next(ui + 1, nxt);
        if constexpr (GATHER) { if (has_next) { PG8_LOAD_OFF(offN, nxt); } else {
#pragma unroll
            for (int _h = 0; _h < 2; ++_h) { offN[_h][0] = offC[_h][0]; offN[_h][1] = offC[_h][1]; } } }
        const char* nA = GATHER ? (const char*)g.A : (has_next ? (const char*)g.A + (size_t)nxt.pm * tstep : cA); const char* nB = has_next ? (const char*)g.Bt + (size_t)nxt.e * S.bstride + (size_t)nxt.pn * tstep : cB;
        for (int t = 0; t < nt; t += 2) {
            const bool last = (t == nt - 2);
            const char* a1 = cA + (size_t)(t + 1) * kstep;
            const char* a2 = last ? nA : cA + (size_t)(t + 2) * kstep; const char* b2 = last ? nB : cB + (size_t)(t + 2) * kstep;
            const char* a3 = a2 + kstep; const char* b3 = b2 + kstep;
            PG8_LDB(B0, 0, 0); PG8_LDB(B1, 0, 1); PG8_SCHED; PG8_LDA(At, 0, 0); PG8_STAGE_A(PG8_SA(1, 1), a1, 1, false);
            PG8_WAIT_V(8); PG8_WAIT_L(0); PG8_BAR; PG8_MMA(0, 0, At, B0); PG8_MMA(0, 1, At, B1); PG8_BAR; PG8_SCHED;
            PG8_LDA(At, 0, 1); PG8_STAGE(PG8_SB(0, 0), b2, voffB); PG8_STAGE(PG8_SB(0, 1), b2 + hstep, voffB); PG8_STAGE_A(PG8_SA(0, 0), a2, 0, last);
            PG8_WAIT_V(8); PG8_WAIT_L(0); PG8_BAR; PG8_MMA(1, 0, At, B0); PG8_MMA(1, 1, At, B1); PG8_BAR; PG8_SCHED;
            PG8_LDB(B0, 1, 0); PG8_LDB(B1, 1, 1); PG8_SCHED; PG8_LDA(At, 1, 0); PG8_STAGE_A(PG8_SA(0, 1), a2, 1, last);
            PG8_WAIT_V(8); PG8_WAIT_L(0); PG8_BAR; PG8_MMA(0, 0, At, B0); PG8_MMA(0, 1, At, B1); PG8_BAR; PG8_SCHED;
            PG8_LDA(At, 1, 1); PG8_STAGE(PG8_SB(1, 0), b3, voffB); PG8_STAGE(PG8_SB(1, 1), b3 + hstep, voffB); PG8_STAGE_A(PG8_SA(1, 0), a3, 0, last);
            PG8_WAIT_V(8); PG8_WAIT_L(0); PG8_BAR; PG8_MMA(1, 0, At, B0); PG8_MMA(1, 1, At, B1); PG8_BAR; PG8_SCHED;
        }
        if constexpr (ALIGN_EPI) { if (wr == 0) PG8_BAR; }
        E(acc, cur, wr, wc, fr, fq);
        if (!has_next) break;
#pragma unroll
        for (int a = 0; a < 2; ++a)
#pragma unroll
            for (int b = 0; b < 2; ++b)
#pragma unroll
                for (int m = 0; m < 4; ++m)
#pragma unroll
                    for (int n = 0; n < 2; ++n) acc[a][b][m][n] = (f32x4){0.f, 0.f, 0.f, 0.f};
        cur = nxt; cA = nA; cB = nB; ++ui;
        if constexpr (GATHER) {
#pragma unroll
            for (int _h = 0; _h < 2; ++_h) { offC[_h][0] = offN[_h][0]; offC[_h][1] = offN[_h][1]; } }
        if constexpr (ALIGN_EPI) { if (wr == 1) PG8_BAR; }
    }
    PG8_WAIT_V(0);
    if constexpr (!ALIGN_EPI) { if (wr == 0) PG8_BAR; }
    PG8_BAR;
#undef PG8_SA
#undef PG8_SB
#undef PG8_STAGE
#undef PG8_STAGE_A
#undef PG8_LOAD_OFF
#undef PG8_LDA
#undef PG8_LDB
#undef PG8_MMA
#undef PG8_WAIT_V
#undef PG8_WAIT_L
#undef PG8_BAR
#undef PG8_SCHED
}
}

struct Args { const float* in[24]; float* out; unsigned char* ws; int ph_lo, ph_hi; };
enum { I_X = 0, I_C, I_CTX, I_CCTX, I_WADA, I_BADA, I_N1G, I_N2G, I_WIN, I_QNG, I_KNG, I_SINK, I_CONVW, I_CONVB, I_LWR, I_LBR, I_LWI, I_LBI, I_LAM, I_WOUT, I_WROUTER, I_WGATE, I_WUP, I_WDOWN };

constexpr int N_ITEMS_ALL = 16 * 56 + 16 * 32 + 3 * NE * 16 * 32;
constexpr int N_ITEMS_P0 = 16 * 56 + 16 * 32;
constexpr int DEFER_PER_WAVE = 6, N_DEFER = 144 * NWAVES * DEFER_PER_WAVE;
struct TItem { const float* W; int N, k0, n0; bf16_t* dst; };
__device__ __forceinline__ TItem decode_item(const Args& a, unsigned char* ws, int it) {
    constexpr int I_IN = 16 * 56, I_OUT = 16 * 32, I_EXP = 16 * 32;
    bf16_t* WinT = (bf16_t*)(ws + WS_WIN); bf16_t* WoutT = (bf16_t*)(ws + WS_WOUT); bf16_t* WupT = (bf16_t*)(ws + WS_WUP); bf16_t* WdnT = (bf16_t*)(ws + WS_WDN);
    TItem t; int r = it;
    if (r < I_IN) { const int kb = r / 56, nb = r % 56; t.W = a.in[I_WIN]; t.N = NIN; t.k0 = 64 * kb; t.n0 = 32 * nb; t.dst = WinT + (size_t)(32 * nb) * DM; return t; } r -= I_IN;
    if (r < I_OUT) { const int kb = r / 32, nb = r % 32; t.W = a.in[I_WOUT]; t.N = DM; t.k0 = 64 * kb; t.n0 = 32 * nb; t.dst = WoutT + (size_t)(32 * nb) * DM; return t; } r -= I_OUT;
    const int which = r / (NE * I_EXP); r -= which * NE * I_EXP;
    const int e = r / I_EXP; r -= e * I_EXP; const int kb = r / 32, nb = r % 32, n0 = 32 * nb;
    t.N = DM; t.k0 = 64 * kb; t.n0 = n0;
    if (which == 0)      { t.W = a.in[I_WGATE] + (size_t)e * DM * DM; t.dst = WupT + ((size_t)e * 2048 + 256 * (n0 >> 7) + (n0 & 127)) * DM; }
    else if (which == 1) { t.W = a.in[I_WUP] + (size_t)e * DM * DM;   t.dst = WupT + ((size_t)e * 2048 + 256 * (n0 >> 7) + 128 + (n0 & 127)) * DM; }
    else                 { t.W = a.in[I_WDOWN] + (size_t)e * DM * DM; t.dst = WdnT + ((size_t)e * 1024 + n0) * DM; }
    return t;
}
__device__ __forceinline__ void transpose_store(const TItem& t, LAS float* scr, int lane) {
    const int c = lane & 7;
#pragma unroll
    for (int j = 0; j < 4; ++j) { const int n = (lane >> 3) + 8 * j; const LAS float* s = scr + (8 * c) * 33 + n;
        u32x4 o; o.x = pk2(s[0 * 33], s[1 * 33]); o.y = pk2(s[2 * 33], s[3 * 33]); o.z = pk2(s[4 * 33], s[5 * 33]); o.w = pk2(s[6 * 33], s[7 * 33]);
        *(u32x4*)(t.dst + (size_t)n * DM + t.k0 + 8 * c) = o; }
}
__device__ __forceinline__ void transpose_pair(const TItem& t0, const TItem& t1, bool two, LAS float* scr, int lane) {
    float tv0[32], tv1[32];
#pragma unroll
    for (int i = 0; i < 32; ++i) { const int kk = 2 * i + (lane >> 5); tv0[i] = t0.W[(size_t)(t0.k0 + kk) * t0.N + t0.n0 + (lane & 31)]; }
    if (two) {
#pragma unroll
        for (int i = 0; i < 32; ++i) { const int kk = 2 * i + (lane >> 5); tv1[i] = t1.W[(size_t)(t1.k0 + kk) * t1.N + t1.n0 + (lane & 31)]; }
    }
#pragma unroll
    for (int i = 0; i < 32; ++i) { const int kk = 2 * i + (lane >> 5); scr[kk * 33 + (lane & 31)] = tv0[i]; }
    if (two) {
#pragma unroll
        for (int i = 0; i < 32; ++i) { const int kk = 2 * i + (lane >> 5); scr[2112 + kk * 33 + (lane & 31)] = tv1[i]; }
    }
    asm volatile("s_waitcnt lgkmcnt(0)" ::: "memory");
    transpose_store(t0, scr, lane);
    if (two) transpose_store(t1, scr + 2112, lane);
    asm volatile("s_waitcnt lgkmcnt(0)" ::: "memory");
}

__device__ __forceinline__ void phase0(const Args& a, LAS unsigned char* lds) {
    const int tid = threadIdx.x, lane = tid & 63, wid = tid >> 6;
    unsigned char* ws = a.ws;
    if (blockIdx.x < 48) {
        const int item = blockIdx.x;
        LAS float* sc = (LAS float*)lds;
        LAS float* accL = (LAS float*)(lds + 17 * 1024 * 4);
        for (int i = tid; i < 17 * 1024; i += NTHREADS) { const int r = i >> 10, k = i & 1023; const float v = (r < 16) ? a.in[I_C][r * 1024 + k] : a.in[I_CCTX][k]; sc[i] = v / (1.0f + __expf(-v)); }
        for (int i = tid; i < 17 * 128; i += NTHREADS) accL[i] = 0.f;
        __syncthreads();
        const int kg = tid >> 5, cl = tid & 31;
        f32x4 acc[17];
#pragma unroll
        for (int r = 0; r < 17; ++r) acc[r] = (f32x4){0.f, 0.f, 0.f, 0.f};
        const float* wp = a.in[I_WADA] + (size_t)(kg * 64) * 6144 + item * 128 + 4 * cl;
        for (int k8 = 0; k8 < 64; k8 += 8) {
            f32x4 w[8];
#pragma unroll
            for (int u = 0; u < 8; ++u) w[u] = *(const f32x4*)(wp + (size_t)(k8 + u) * 6144);
#pragma unroll
            for (int u = 0; u < 8; ++u)
#pragma unroll
                for (int r = 0; r < 17; ++r) acc[r] += w[u] * sc[r * 1024 + kg * 64 + k8 + u];
        }
        for (int round = 0; round < 16; ++round) {
            if (kg == round) {
#pragma unroll
                for (int r = 0; r < 17; ++r) { LAS f32x4* p = (LAS f32x4*)(accL + r * 128 + 4 * cl); *p = *p + acc[r]; }
            }
            __syncthreads();
        }
        float* mod = (float*)(ws + WS_MOD);
        for (int i = tid; i < 17 * 128; i += NTHREADS) { const int r = i >> 7, cc = i & 127; mod[r * 6144 + item * 128 + cc] = accL[i] + a.in[I_BADA][item * 128 + cc]; }
        __syncthreads();
    }
    for (int f = blockIdx.x * NTHREADS + tid; f < 16384; f += gridDim.x * NTHREADS) {
        const int ln = f & 63, s = (f >> 6) & 3, ct = (f >> 8) & 1, mat = (f >> 9) & 1, dn = f >> 10;
        const float* w = a.in[mat ? I_LWI : I_LWR] + (size_t)dn * 4096 + ct * 32 + (ln & 31);
        float t8[8];
#pragma unroll
        for (int jj = 0; jj < 8; ++jj) t8[jj] = w[(16 * s + 8 * (ln >> 5) + jj) * 64];
        *(bf16x8*)(ws + WS_LW + (size_t)f * 16) = pack8(t8);
    }
    LAS float* scr = (LAS float*)(lds + wid * 16896);
    const int gw = blockIdx.x * NWAVES + wid, NGW = gridDim.x * NWAVES;
    const int NITEMS = (gridDim.x == 256) ? N_ITEMS_P0 : N_ITEMS_ALL;
    for (int it = gw; it < NITEMS; it += 2 * NGW) {
        const bool two = (it + NGW) < NITEMS;
        const TItem t0 = decode_item(a, ws, it); const TItem t1 = decode_item(a, ws, two ? it + NGW : it);
        transpose_pair(t0, t1, two, scr, lane);
    }
}

__device__ __forceinline__ void deferred_weight_copies(const Args& a, LAS unsigned char* lds) {
    if (gridDim.x != 256 || blockIdx.x < 112) return;
    const int lane = threadIdx.x & 63, wid = threadIdx.x >> 6;
    LAS float* scr = (LAS float*)(lds + wid * 16896);
    const int w = (blockIdx.x - 112) * NWAVES + wid;
    const int base = N_ITEMS_ALL - N_DEFER + w * DEFER_PER_WAVE;
#pragma unroll 1
    for (int i = 0; i < DEFER_PER_WAVE; i += 2) {
        const TItem t0 = decode_item(a, a.ws, base + i); const TItem t1 = decode_item(a, a.ws, base + i + 1);
        transpose_pair(t0, t1, true, scr, lane);
    }
}

__device__ __forceinline__ void load_row(const float* src, int lane, f32x4* v) {
#pragma unroll
    for (int j = 0; j < 4; ++j) v[j] = *((const f32x4*)src + lane + 64 * j);
}
__device__ __forceinline__ void norm_mod_vals(const f32x4* v, const float* gn, const float* shift, const float* scale, bf16_t* dst, int lane, f32x4* keep) {
    float s = 0.f;
#pragma unroll
    for (int j = 0; j < 4; ++j) s += (v[j].x * v[j].x + v[j].y * v[j].y) + (v[j].z * v[j].z + v[j].w * v[j].w);
    const float rstd = rsqrtf(wave_sum(s) * (1.0f / DM) + EPSN);
#pragma unroll
    for (int j = 0; j < 4; ++j) {
        const f32x4 g = *((const f32x4*)gn + lane + 64 * j), sh = *((const f32x4*)shift + lane + 64 * j), sc = *((const f32x4*)scale + lane + 64 * j);
        const f32x4 o = (v[j] * rstd * g) * (sc + 1.0f) + sh;
        if (keep) keep[j] = o;
        u32x2 w; w.x = pk2(o.x, o.y); w.y = pk2(o.z, o.w);
        *((u32x2*)dst + lane + 64 * j) = w;
    }
}
__device__ __forceinline__ const float* p1_src(const Args& a, int m) { return (m < ML) ? a.in[I_X] + (size_t)m * DM : a.in[I_CTX] + (size_t)(m - ML) * DM; }
__device__ __forceinline__ void phase1(const Args& a) {
    const int lane = threadIdx.x & 63, wid = threadIdx.x >> 6;
    const int gw = blockIdx.x * NWAVES + wid, NGW = gridDim.x * NWAVES;
    const float* mod = (const float*)(a.ws + WS_MOD); bf16_t* H = (bf16_t*)(a.ws + WS_H);
    for (int m0 = gw; m0 < MT; m0 += 4 * NGW) {
        f32x4 v[4][4];
#pragma unroll
        for (int r = 0; r < 4; ++r) { const int m = m0 + r * NGW; if (m < MT) load_row(p1_src(a, m), lane, v[r]); }
#pragma unroll
        for (int r = 0; r < 4; ++r) { const int m = m0 + r * NGW;
            if (m < MT) { const int mr = (m < ML) ? (m >> 12) : 16; norm_mod_vals(v[r], a.in[I_N1G], mod + mr * 6144, mod + mr * 6144 + 1024, H + (size_t)m * DM, lane, nullptr); } }
    }
}

__device__ __forceinline__ void attn_unit(const Args& a, LAS unsigned char* lds, int unit) {
    int tid_ = threadIdx.x; asm volatile("" : "+v"(tid_));
    const int tid = tid_, lane = tid & 63, wid = __builtin_amdgcn_readfirstlane(tid >> 6), r32 = lane & 31, hi = lane >> 5;
    const int b = unit >> 6, hk = (unit >> 5) & 1, qb = unit & 31;
    const int g = wid >> 1, hq = hk * 4 + g, qhalf = wid & 1;
    const bf16_t* QKV = (const bf16_t*)(a.ws + WS_QKV);
    bf16_t* AO = (bf16_t*)(a.ws + WS_AO);
    LAS unsigned char* Kl = lds;
    LAS unsigned char* Vl = lds + 16384;
    const float FR = 0.8304820237218406f;
    bf16x8 qf[2][4];
#pragma unroll
    for (int qt = 0; qt < 2; ++qt) {
        const int t = qb * 128 + qhalf * 64 + qt * 32 + r32;
        const bf16_t* qp = QKV + (size_t)(b * SEQL + t) * NIN + hq * 64 + 8 * hi;
        float x[4][8]; float ss = 0.f;
#pragma unroll
        for (int s = 0; s < 4; ++s) { unpack8(*(const u32x4*)(qp + 16 * s), x[s]);
#pragma unroll
            for (int j = 0; j < 8; ++j) ss += x[s][j] * x[s][j]; }
        ss += __shfl_xor(ss, 32);
        const float rstd = rsqrtf(ss * (1.0f / 64.0f) + EPSN);
#pragma unroll
        for (int s = 0; s < 4; ++s)
#pragma unroll
            for (int j = 0; j < 8; ++j) x[s][j] *= rstd * a.in[I_QNG][16 * s + 8 * hi + j];
        const float prow = (float)(t >> 6), pcol = (float)(t & 63);
        const float C2 = 0.125f * LOG2E;
#pragma unroll
        for (int j = 0; j < 8; ++j) {
            const float invf = exp2f(-(float)(8 * hi + j) * FR);
            float sn, cs;
            sn = __sinf(prow * invf); cs = __cosf(prow * invf);
            { const float x1 = x[0][j], x2 = x[1][j]; x[0][j] = (x1 * cs - x2 * sn) * C2; x[1][j] = (x2 * cs + x1 * sn) * C2; }
            sn = __sinf(pcol * invf); cs = __cosf(pcol * invf);
            { const float x1 = x[2][j], x2 = x[3][j]; x[2][j] = (x1 * cs - x2 * sn) * C2; x[3][j] = (x2 * cs + x1 * sn) * C2; }
        }
#pragma unroll
        for (int s = 0; s < 4; ++s) qf[qt][s] = pack8(x[s]);
    }
    float mrun[2], lsum[2]; f32x16 O[2][2];
    float sinit; bool fixedref;
    { const float sk = a.in[I_SINK][hq] * LOG2E;
      float gq = fabsf(a.in[I_QNG][lane]), gk = fabsf(a.in[I_KNG][lane]);
#pragma unroll
      for (int o = 1; o < 64; o <<= 1) { gq = fmaxf(gq, __shfl_xor(gq, o)); gk = fmaxf(gk, __shfl_xor(gk, o)); }
      const float mref = fmaxf(8.0f * gq * gk * LOG2E * 1.02f + 0.01f, sk);
      fixedref = mref < 64.0f; sinit = fixedref ? -mref : 0.f;
#pragma unroll
      for (int qt = 0; qt < 2; ++qt) { mrun[qt] = sk; lsum[qt] = hi ? 0.f : (fixedref ? __builtin_amdgcn_exp2f(sk - mref) : 1.f); O[qt][0] = f32x16{}; O[qt][1] = f32x16{}; } }

    const int skey = tid >> 2, sp = tid & 3, sa = sp >> 1, sfh = sp & 1;
#define CHUNK_VALID(cc) ((cc) < 2 || ((qb - 1 + ((cc) - 2)) >= 0 && (qb - 1 + ((cc) - 2)) <= 31))
#define CHUNK_ROW0(cc) ((cc) < 2 ? ((size_t)ML + b * LCTX + (cc) * 128) : ((size_t)b * SEQL + (qb - 1 + ((cc) - 2)) * 128))
#define LOAD_KV(cc) do { const size_t kr_ = CHUNK_ROW0(cc) + skey; const bf16_t* kp_ = QKV + kr_ * NIN + 512 + hk * 64 + sa * 32 + 8 * sfh; pk1 = *(const u32x4*)kp_; pk2_ = *(const u32x4*)(kp_ + 16); \
        const bf16_t* vp_ = QKV + kr_ * NIN + 640 + hk * 64 + 16 * sp; pv0 = *(const u32x4*)vp_; pv1 = *(const u32x4*)(vp_ + 8); } while (0)
    u32x4 pk1, pk2_, pv0, pv1;
    LOAD_KV(0);
    for (int c = 0; c < 5; ++c) {
        if (!CHUNK_VALID(c)) continue;
        const int kb = (c < 2) ? 0 : qb - 1 + (c - 2);
        __syncthreads();
        {
            int sfh_ = sfh, sa_ = sa; asm volatile("" : "+v"(sfh_), "+v"(sa_));
            float x1[8], x2[8]; unpack8(pk1, x1); unpack8(pk2_, x2);
            const u32x4 v0 = pv0, v1 = pv1;
            { int cn = c + 1; if (cn < 5 && !CHUNK_VALID(cn)) ++cn; if (cn < 5 && CHUNK_VALID(cn)) LOAD_KV(cn); }
            float ss = 0.f;
#pragma unroll
            for (int j = 0; j < 8; ++j) ss += x1[j] * x1[j] + x2[j] * x2[j];
            ss += __shfl_xor(ss, 1); ss += __shfl_xor(ss, 2);
            const float rstd = rsqrtf(ss * (1.0f / 64.0f) + EPSN);
            const int tk = kb * 128 + skey; const float pos = sa ? (float)(tk & 63) : (float)(tk >> 6);
#pragma unroll
            for (int j = 0; j < 8; ++j) {
                float v1_ = x1[j] * rstd * a.in[I_KNG][sa_ * 32 + 8 * sfh_ + j], v2_ = x2[j] * rstd * a.in[I_KNG][sa_ * 32 + 16 + 8 * sfh_ + j];
                if (c >= 2) { const float ang = pos * __builtin_amdgcn_exp2f(-(float)(8 * sfh_ + j) * FR); const float sn = __sinf(ang), cs = __cosf(ang); const float o1 = v1_ * cs - v2_ * sn, o2 = v2_ * cs + v1_ * sn; v1_ = o1; v2_ = o2; }
                x1[j] = v1_; x2[j] = v2_;
            }
            *(LAS bf16x8*)(Kl + (4 * sa + sfh) * 2048 + skey * 16) = pack8(x1);
            *(LAS bf16x8*)(Kl + (4 * sa + 2 + sfh) * 2048 + skey * 16) = pack8(x2);
            *(LAS u32x4*)(Vl + (sp >> 1) * 8192 + skey * 64 + (sp & 1) * 32) = v0;
            *(LAS u32x4*)(Vl + (sp >> 1) * 8192 + skey * 64 + (sp & 1) * 32 + 16) = v1;
        }
        __syncthreads();
        for (int kt = 0; kt < 4; ++kt) {
            if (c == 2 && kt < qhalf * 2) continue;
            if (c == 4 && kt > qhalf * 2 + 1) continue;
            bf16x8 kf[4];
#pragma unroll
            for (int s = 0; s < 4; ++s) kf[s] = *(const LAS bf16x8*)(Kl + (2 * s + hi) * 2048 + (kt * 32 + r32) * 16);
            bf16x8 pf[2][2];
#pragma unroll
            for (int qt = 0; qt < 2; ++qt) {
                f32x16 S;
#pragma unroll
                for (int r = 0; r < 16; ++r) S[r] = sinit;
                __builtin_amdgcn_s_setprio(1);
#pragma unroll
                for (int s = 0; s < 4; ++s) S = __builtin_amdgcn_mfma_f32_32x32x16_bf16(kf[s], qf[qt][s], S, 0, 0, 0);
                __builtin_amdgcn_s_setprio(0);
                const int qq = qhalf * 64 + qt * 32 + r32;
                if (c == 2) {
#pragma unroll
                    for (int r = 0; r < 16; ++r) { const int kk = kt * 32 + crow(r, hi); if (kk < qq) S[r] = -1e30f; }
                } else if (c == 4) {
#pragma unroll
                    for (int r = 0; r < 16; ++r) { const int kk = kt * 32 + crow(r, hi); if (kk > qq) S[r] = -1e30f; }
                }
                if (fixedref) {
                    float ps = 0.f;
#pragma unroll
                    for (int r = 0; r < 16; ++r) { S[r] = __builtin_amdgcn_exp2f(S[r]); ps += S[r]; }
                    lsum[qt] += ps;
                } else {
                    float mx = S[0];
#pragma unroll
                    for (int r = 1; r < 16; ++r) mx = fmaxf(mx, S[r]);
                    mx = fmaxf(mx, __shfl_xor(mx, 32));
                    const float mnew = fmaxf(mrun[qt], mx), alpha = __builtin_amdgcn_exp2f(mrun[qt] - mnew);
                    mrun[qt] = mnew;
                    float ps = 0.f;
#pragma unroll
                    for (int r = 0; r < 16; ++r) { S[r] = __builtin_amdgcn_exp2f(S[r] - mnew); ps += S[r]; }
                    lsum[qt] = lsum[qt] * alpha + ps;
#pragma unroll
                    for (int r = 0; r < 16; ++r) { O[qt][0][r] *= alpha; O[qt][1][r] *= alpha; }
                }
#pragma unroll
                for (int s2 = 0; s2 < 2; ++s2) { u32x4 w; w.x = pg8::cvt_pk_bf16(S[8 * s2 + 0], S[8 * s2 + 1]); w.y = pg8::cvt_pk_bf16(S[8 * s2 + 2], S[8 * s2 + 3]); w.z = pg8::cvt_pk_bf16(S[8 * s2 + 4], S[8 * s2 + 5]); w.w = pg8::cvt_pk_bf16(S[8 * s2 + 6], S[8 * s2 + 7]); pf[qt][s2] = __builtin_bit_cast(bf16x8, w); }
            }
            const int gi = lane >> 4, li = lane & 15;
#pragma unroll
            for (int dt = 0; dt < 2; ++dt)
#pragma unroll
                for (int s2 = 0; s2 < 2; ++s2) {
                    const LAS unsigned char* vpz = Vl + dt * 8192 + (kt * 32 + 16 * s2 + 4 * hi + (li >> 2)) * 64 + (16 * (gi & 1) + 4 * (li & 3)) * 2;
                    const s16x4 lo = __builtin_bit_cast(s16x4, __builtin_amdgcn_ds_read_tr16_b64_v4i16((LAS s16x4*)vpz));
                    const s16x4 hh = __builtin_bit_cast(s16x4, __builtin_amdgcn_ds_read_tr16_b64_v4i16((LAS s16x4*)(vpz + 512)));
                    const bf16x8 vf = (bf16x8){lo[0], lo[1], lo[2], lo[3], hh[0], hh[1], hh[2], hh[3]};
                    __builtin_amdgcn_s_setprio(1);
#pragma unroll
                    for (int qt = 0; qt < 2; ++qt) O[qt][dt] = __builtin_amdgcn_mfma_f32_32x32x16_bf16(vf, pf[qt][s2], O[qt][dt], 0, 0, 0);
                    __builtin_amdgcn_s_setprio(0);
                }
        }
    }
#pragma unroll
    for (int qt = 0; qt < 2; ++qt) {
        const float l = lsum[qt] + __shfl_xor(lsum[qt], 32), inv = 1.0f / l;
        const int t = qb * 128 + qhalf * 64 + qt * 32 + r32;
        bf16_t* op = AO + (size_t)(b * SEQL + t) * DM + hq * 64;
#pragma unroll
        for (int dt = 0; dt < 2; ++dt)
#pragma unroll
            for (int rr = 0; rr < 4; ++rr) { u32x2 w; w.x = pk2(O[qt][dt][4 * rr] * inv, O[qt][dt][4 * rr + 1] * inv); w.y = pk2(O[qt][dt][4 * rr + 2] * inv, O[qt][dt][4 * rr + 3] * inv);
                *(u32x2*)(op + 32 * dt + 8 * rr + 4 * hi) = w; }
    }
}

__device__ __forceinline__ float gelu_tanh(float x) { const float u = 0.7978845608028654f * (x + 0.044715f * x * x * x); const float t = 1.0f - 2.0f / (1.0f + __expf(2.0f * u)); return 0.5f * x * (1.0f + t); }
__device__ __forceinline__ float fast_sigmoid(float x) { return __builtin_amdgcn_rcpf(1.0f + __builtin_amdgcn_exp2f(-x * LOG2E)); }
__device__ __forceinline__ float gelu_fast(float x) { const float u = 0.7978845608028654f * (x + 0.044715f * x * x * x); const float t = 1.0f - 2.0f * __builtin_amdgcn_rcpf(1.0f + __builtin_amdgcn_exp2f(2.0f * LOG2E * u)); return 0.5f * x * (1.0f + t); }
template <int MODE>
__device__ __forceinline__ void lru_phase(const Args& a, LAS unsigned char* lds) {
    const int tid = threadIdx.x, lane = tid & 63, wid = __builtin_amdgcn_readfirstlane(tid >> 6), r32 = lane & 31, hi = lane >> 5;
    const bf16_t* QKV = (const bf16_t*)(a.ws + WS_QKV);
    bf16_t* AO = (bf16_t*)(a.ws + WS_AO);
    float* AGG = (float*)(a.ws + WS_AGG);
    const u32x4* LW = (const u32x4*)(a.ws + WS_LW);
    LAS float* xcf = (LAS float*)lds;
    LAS u32x4* wL = (LAS u32x4*)(lds + 34816);
    LAS bf16_t* grL = (LAS bf16_t*)(lds + 67584);
    LAS float* wtA = (LAS float*)(lds + 83968);
    LAS float* wtB = (LAS float*)(lds + 86016);
    LAS float* cwL = (LAS float*)(lds + 88064);
    LAS float* carL = (LAS float*)(lds + 89344);
    LAS float* stg = (LAS float*)(lds + 100352);
    const int tt = wid & 3, ct = wid >> 2;
    const int ctok = tid >> 2, ccg = tid & 3;
    const int jch = ct * 32 + r32;
    for (int v = blockIdx.x; v < 256; v += gridDim.x) {
        const int n = v & 7, b = v >> 4, half = (v >> 3) & 1;
        const int ch0 = n * 64 + 16 * ccg;
        __syncthreads();
        if (tid < 320) { const int r = tid >> 6, c = tid & 63; cwL[tid] = (r < 4) ? a.in[I_CONVW][r * 512 + n * 64 + c] : a.in[I_CONVB][n * 64 + c]; }
        for (int i = tid; i < 2048; i += NTHREADS) wL[i] = LW[(size_t)(((i >> 10) * 8 + n) * 1024) + (i & 1023)];
        float nbr[2], nbi[2], c8[2];
#pragma unroll
        for (int dir = 0; dir < 2; ++dir) {
            const int chj = n * 64 + jch;
            nbr[dir] = -a.in[I_LBR][dir * 512 + chj] * LOG2E; nbi[dir] = -a.in[I_LBI][dir * 512 + chj] * LOG2E;
            const float lam = a.in[I_LAM][dir * 512 + chj];
            c8[dir] = -8.0f * ((lam > 15.f) ? __expf(-lam) : log1pf(__expf(-lam)));
        }
        if (MODE == 1) {
            const float* ag = AGG + ((size_t)((b * 8 + n) * 2) * 34) * 128;
            for (int i = tid; i < 2 * 34 * 32; i += NTHREADS) *(LAS f32x4*)(stg + 4 * i) = *(const f32x4*)(ag + 4 * i);
            __syncthreads();
            if (tid < 128) { const int dir = wid, c = lane; const LAS float* al = stg + dir * 34 * 128 + c;
                float h = 0.f;
                for (int s2 = 0; s2 < 34; ++s2) { const int T = dir ? 33 - s2 : s2 - 2; const int k = T - 16 * half;
                    if (s2 >= 2 && k >= 0 && k < 16) carL[(dir * 17 + k) * 64 + c] = h;
                    if (dir == (half ? 0 : 1) && s2 >= 2 && k >= 0 && k < 16) break;
                    h = al[s2 * 128] * h + al[s2 * 128 + 64]; } }
        }
        __syncthreads();
        const int NT = (MODE == 0) ? 17 : 16;
        u32x4 xin[4][2], gin[2];
#define LOAD_INPUTS(TL) do { const int tl_ = (TL); const bool isctx_ = tl_ < 2; const int tile_ = isctx_ ? tl_ : tl_ - 2; const int LS_ = isctx_ ? LCTX : SEQL; \
            const size_t rowbase_ = isctx_ ? ((size_t)ML + b * LCTX) : ((size_t)b * SEQL); const int tok_ = tile_ * 128 + ctok; \
            _Pragma("unroll") for (int j = 0; j < 4; ++j) { const int tj = tok_ + j - 2; \
                if (tj >= 0 && tj < LS_) { const bf16_t* xp = QKV + (rowbase_ + tj) * NIN + 768 + ch0; xin[j][0] = *(const u32x4*)xp; xin[j][1] = *(const u32x4*)(xp + 8); } \
                else { xin[j][0] = (u32x4){0u, 0u, 0u, 0u}; xin[j][1] = (u32x4){0u, 0u, 0u, 0u}; } } \
            if (MODE == 1) { const bf16_t* gp = QKV + (rowbase_ + tok_) * NIN + 1280 + ch0; gin[0] = *(const u32x4*)gp; gin[1] = *(const u32x4*)(gp + 8); } } while (0)
        const int tl0 = (MODE == 0) ? 17 * half : 2 + 16 * half;
        const bool desc = (MODE == 1) && (half == 0);
        LOAD_INPUTS(desc ? tl0 + NT - 1 : tl0);
        for (int i = 0; i < NT; ++i) {
            const int k = desc ? NT - 1 - i : i;
            const int tl = tl0 + k;
            const bool isctx = tl < 2; const int tile = isctx ? tl : tl - 2;
            const size_t rowbase = isctx ? ((size_t)ML + b * LCTX) : ((size_t)b * SEQL);
            const int t0 = tile * 128;
            {
                float acc[16];
#pragma unroll
                for (int q = 0; q < 4; ++q) { const f32x4 bv = *(const LAS f32x4*)(cwL + 4 * 64 + 16 * ccg + 4 * q); acc[4 * q] = bv.x; acc[4 * q + 1] = bv.y; acc[4 * q + 2] = bv.z; acc[4 * q + 3] = bv.w; }
#pragma unroll
                for (int j = 0; j < 4; ++j) { float xv[16]; unpack8(xin[j][0], xv); unpack8(xin[j][1], xv + 8);
#pragma unroll
                    for (int q = 0; q < 4; ++q) { const f32x4 wv = *(const LAS f32x4*)(cwL + j * 64 + 16 * ccg + 4 * q);
                        acc[4 * q] += wv.x * xv[4 * q]; acc[4 * q + 1] += wv.y * xv[4 * q + 1]; acc[4 * q + 2] += wv.z * xv[4 * q + 2]; acc[4 * q + 3] += wv.w * xv[4 * q + 3]; } }
#pragma unroll
                for (int q = 0; q < 4; ++q) *(LAS f32x4*)(xcf + ctok * 68 + 16 * ccg + 4 * q) = (f32x4){acc[4 * q], acc[4 * q + 1], acc[4 * q + 2], acc[4 * q + 3]};
                if (MODE == 1) { *(LAS u32x4*)(grL + ctok * 64 + 16 * ccg) = gin[0]; *(LAS u32x4*)(grL + ctok * 64 + 16 * ccg + 8) = gin[1]; }
            }
            if (i + 1 < NT) LOAD_INPUTS(desc ? tl - 1 : tl + 1);
            __syncthreads();
            LAS float* hfL = stg;
#pragma unroll
            for (int dir = 0; dir < 2; ++dir) {
                if (MODE == 0 && dir == 0 && tl >= 18) continue;
                if (MODE == 0 && dir == 1 && tl >= 2 && tl <= 17) continue;
                float av[16], bv[16];
                {
                    f32x16 accR = f32x16{}, accI = f32x16{};
#pragma unroll
                    for (int s = 0; s < 4; ++s) { const LAS float* xp = xcf + (tt * 32 + r32) * 68 + 16 * s + 8 * hi; const f32x4 p0 = *(const LAS f32x4*)xp, p1 = *(const LAS f32x4*)(xp + 4);
                        float t8[8] = {p0.x, p0.y, p0.z, p0.w, p1.x, p1.y, p1.z, p1.w}; const bf16x8 af = pack8(t8);
                        const bf16x8 wrf = __builtin_bit_cast(bf16x8, wL[(((dir * 2 + 0) * 2 + ct) * 4 + s) * 64 + lane]), wif = __builtin_bit_cast(bf16x8, wL[(((dir * 2 + 1) * 2 + ct) * 4 + s) * 64 + lane]);
                        accR = __builtin_amdgcn_mfma_f32_32x32x16_bf16(af, wrf, accR, 0, 0, 0); accI = __builtin_amdgcn_mfma_f32_32x32x16_bf16(af, wif, accI, 0, 0, 0); }
                    const float cc8 = c8[dir], nr = nbr[dir], ni = nbi[dir];
#define LRU_GATE_LOOP(FALLBACK) _Pragma("unroll") for (int r = 0; r < 16; ++r) { const int tau = tt * 32 + crow(r, hi); \
                        const float rg = __builtin_amdgcn_rcpf(1.0f + __builtin_amdgcn_exp2f(__builtin_fmaf(accR[r], -LOG2E, nr))), ig = __builtin_amdgcn_rcpf(1.0f + __builtin_amdgcn_exp2f(__builtin_fmaf(accI[r], -LOG2E, ni))), xv = xcf[tau * 68 + jch]; \
                        const float log_a = cc8 * rg; av[r] = __builtin_amdgcn_exp2f(log_a * LOG2E); \
                        const float x2 = 2.0f * log_a; \
                        float om = -x2 * (1.0f + x2 * (0.5f + x2 * (0.16666667f + x2 * (0.041666668f + x2 * 0.008333334f)))); \
                        if (FALLBACK) { if (x2 <= -0.25f) om = 1.0f - __builtin_amdgcn_exp2f(x2 * LOG2E); } \
                        bv[r] = __builtin_amdgcn_sqrtf(om) * ig * xv; }
                    if (__builtin_expect(__any(-2.0f * cc8 >= 0.25f), 0)) { LRU_GATE_LOOP(true) } else { LRU_GATE_LOOP(false) }
#undef LRU_GATE_LOOP
                }
                float QA[8], QB[8];
                {
                    float qa[4], qb[4];
#pragma unroll
                    for (int g = 0; g < 4; ++g) { float A = 1.f, Bq = 0.f;
#pragma unroll
                        for (int ee = 0; ee < 4; ++ee) { const int r = 4 * g + (dir ? 3 - ee : ee); Bq = av[r] * Bq + bv[r]; A *= av[r]; }
                        qa[g] = A; qb[g] = Bq; }
#pragma unroll
                    for (int g = 0; g < 4; ++g) { const float pa = __shfl_xor(qa[g], 32), pb = __shfl_xor(qb[g], 32);
                        QA[2 * g] = hi ? pa : qa[g]; QA[2 * g + 1] = hi ? qa[g] : pa; QB[2 * g] = hi ? pb : qb[g]; QB[2 * g + 1] = hi ? qb[g] : pb; }
                }
                {
                    float AW = 1.f, BW = 0.f;
#pragma unroll
                    for (int qq = 0; qq < 8; ++qq) { const int q = dir ? 7 - qq : qq; BW = QA[q] * BW + QB[q]; AW *= QA[q]; }
                    if (hi == 0) { wtA[(dir * 4 + tt) * 64 + jch] = AW; wtB[(dir * 4 + tt) * 64 + jch] = BW; }
                }
                __syncthreads();
                if (MODE == 0) {
                    if (tt == 0 && hi == 0) { float A = 1.f, Bt = 0.f;
#pragma unroll
                        for (int ww = 0; ww < 4; ++ww) { const int w = dir ? 3 - ww : ww; const float sa = wtA[(dir * 4 + w) * 64 + jch], sb = wtB[(dir * 4 + w) * 64 + jch]; Bt = sa * Bt + sb; A *= sa; }
                        const int sig = isctx ? (dir ? 1 - tl : tl) : (dir ? 2 + 31 - tile : 2 + tile);
                        float* ag = AGG + ((size_t)((b * 8 + n) * 2 + dir) * 34 + sig) * 128 + jch; ag[0] = A; ag[64] = Bt; }
                } else {
                    float h = carL[(dir * 17 + k) * 64 + jch];
#pragma unroll
                    for (int ww = 0; ww < 4; ++ww) { const int w = dir ? 3 - ww : ww; const float sa = wtA[(dir * 4 + w) * 64 + jch], sb = wtB[(dir * 4 + w) * 64 + jch];
                        if (dir ? (w > tt) : (w < tt)) h = sa * h + sb; }
                    float hin[4] = {0.f, 0.f, 0.f, 0.f};
#pragma unroll
                    for (int qq = 0; qq < 8; ++qq) { const int q = dir ? 7 - qq : qq; hin[q >> 1] = ((q & 1) == hi) ? h : hin[q >> 1]; h = QA[q] * h + QB[q]; }
                    if (dir == (desc ? 1 : 0) && tt == (desc ? 0 : 3) && hi == 0 && i + 1 < NT) carL[(dir * 17 + (desc ? k - 1 : k + 1)) * 64 + jch] = h;
#pragma unroll
                    for (int g = 0; g < 4; ++g) { float hc = hin[g];
#pragma unroll
                        for (int ee = 0; ee < 4; ++ee) { const int r = 4 * g + (dir ? 3 - ee : ee); hc = av[r] * hc + bv[r];
                            const int tau = tt * 32 + crow(r, hi);
                            if (dir == 0) hfL[tau * 64 + jch] = hc;
                            else xcf[tau * 68 + jch] = (hfL[tau * 64 + jch] + hc) * gelu_fast(bf1(grL[tau * 64 + jch])); } }
                }
            }
            if (MODE == 1) {
                __syncthreads();
                float o[16];
#pragma unroll
                for (int q = 0; q < 4; ++q) { const f32x4 hv = *(const LAS f32x4*)(xcf + ctok * 68 + 16 * ccg + 4 * q); o[4 * q] = hv.x; o[4 * q + 1] = hv.y; o[4 * q + 2] = hv.z; o[4 * q + 3] = hv.w; }
                bf16_t* op = AO + (rowbase + t0 + ctok) * DM + 512 + ch0;
                *(bf16x8*)op = pack8(o); *(bf16x8*)(op + 8) = pack8(o + 8);
            }
        }
#undef LOAD_INPUTS
    }
}

constexpr size_t WS_HS = WS_HF;
constexpr size_t WS_XC = WS_IDX;
template <int PH>
__device__ __forceinline__ void lru_sweep(const Args& a, LAS unsigned char* lds) {
    const int tid = threadIdx.x, lane = tid & 63, wid = __builtin_amdgcn_readfirstlane(tid >> 6), r32 = lane & 31, hi = lane >> 5;
    const bf16_t* QKV = (const bf16_t*)(a.ws + WS_QKV);
    bf16_t* AO = (bf16_t*)(a.ws + WS_AO);
    float* HS = (float*)(a.ws + WS_HS);
    float* XC = (float*)(a.ws + WS_XC);
    const u32x4* LW = (const u32x4*)(a.ws + WS_LW);
    LAS float* xcf = (LAS float*)lds;
    LAS u32x4* wL = (LAS u32x4*)(lds + 34816);
    LAS bf16_t* grL = (LAS bf16_t*)(lds + 67584);
    LAS float* wtA = (LAS float*)(lds + 83968);
    LAS float* wtB = (LAS float*)(lds + 86016);
    LAS float* cwL = (LAS float*)(lds + 88064);
    LAS float* carry = (LAS float*)(lds + 89344);
    const int tt = wid & 3, ct = wid >> 2;
    const int ctok = tid >> 2, ccg = tid & 3;
    const int jch = ct * 32 + r32;
    for (int v = blockIdx.x; v < 256; v += gridDim.x) {
        const int n = v & 7, b = v >> 4, half = (v >> 3) & 1;
        const int dir = (PH == 0) ? half : 1 - half;
        const int ch0 = n * 64 + 16 * ccg;
        __syncthreads();
        if (tid < 320) { const int r = tid >> 6, c = tid & 63; cwL[tid] = (r < 4) ? a.in[I_CONVW][r * 512 + n * 64 + c] : a.in[I_CONVB][n * 64 + c]; }
        for (int i = tid; i < 1024; i += NTHREADS) wL[i] = LW[(size_t)((dir * 8 + n) * 1024) + i];
        if (tid < 64) carry[tid] = (PH == 0) ? 0.f : XC[((size_t)((b * 8 + n) * 2 + dir)) * 64 + tid];
        const int chj = n * 64 + jch;
        const float nr = -a.in[I_LBR][dir * 512 + chj] * LOG2E, ni = -a.in[I_LBI][dir * 512 + chj] * LOG2E;
        const float lam = a.in[I_LAM][dir * 512 + chj];
        const float cc8 = -8.0f * ((lam > 15.f) ? __expf(-lam) : log1pf(__expf(-lam)));
        __syncthreads();
        const int NT = (PH == 0) ? 18 : 16;
        u32x4 xin[4][2], gin[2];
#define SW_TILE(S_, ISCTX, TILE) const bool ISCTX = (PH == 0) && (S_) < 2; \
            const int TILE = (PH == 0) ? (ISCTX ? (dir ? 1 - (S_) : (S_)) : (dir ? 33 - (S_) : (S_) - 2)) : (dir ? 15 - (S_) : 16 + (S_))
#define SW_LOAD(S_) do { SW_TILE(S_, isctx_, tile_); const int LS_ = isctx_ ? LCTX : SEQL; \
            const size_t rowbase_ = isctx_ ? ((size_t)ML + b * LCTX) : ((size_t)b * SEQL); const int tok_ = tile_ * 128 + ctok; \
            _Pragma("unroll") for (int j = 0; j < 4; ++j) { const int tj = tok_ + j - 2; \
                if (tj >= 0 && tj < LS_) { const bf16_t* xp = QKV + (rowbase_ + tj) * NIN + 768 + ch0; xin[j][0] = *(const u32x4*)xp; xin[j][1] = *(const u32x4*)(xp + 8); } \
                else { xin[j][0] = (u32x4){0u, 0u, 0u, 0u}; xin[j][1] = (u32x4){0u, 0u, 0u, 0u}; } } \
            if (PH == 1) { const bf16_t* gp = QKV + (rowbase_ + tok_) * NIN + 1280 + ch0; gin[0] = *(const u32x4*)gp; gin[1] = *(const u32x4*)(gp + 8); } } while (0)
        SW_LOAD(0);
        for (int st = 0; st < NT; ++st) {
            SW_TILE(st, isctx, tile);
            const size_t rowbase = isctx ? ((size_t)ML + b * LCTX) : ((size_t)b * SEQL);
            const int t0 = tile * 128;
            {
                float acc[16];
#pragma unroll
                for (int q = 0; q < 4; ++q) { const f32x4 bv = *(const LAS f32x4*)(cwL + 4 * 64 + 16 * ccg + 4 * q); acc[4 * q] = bv.x; acc[4 * q + 1] = bv.y; acc[4 * q + 2] = bv.z; acc[4 * q + 3] = bv.w; }
#pragma unroll
                for (int j = 0; j < 4; ++j) { float xv[16]; unpack8(xin[j][0], xv); unpack8(xin[j][1], xv + 8);
#pragma unroll
                    for (int q = 0; q < 4; ++q) { const f32x4 wv = *(const LAS f32x4*)(cwL + j * 64 + 16 * ccg + 4 * q);
                        acc[4 * q] += wv.x * xv[4 * q]; acc[4 * q + 1] += wv.y * xv[4 * q + 1]; acc[4 * q + 2] += wv.z * xv[4 * q + 2]; acc[4 * q + 3] += wv.w * xv[4 * q + 3]; } }
#pragma unroll
                for (int q = 0; q < 4; ++q) *(LAS f32x4*)(xcf + ctok * 68 + 16 * ccg + 4 * q) = (f32x4){acc[4 * q], acc[4 * q + 1], acc[4 * q + 2], acc[4 * q + 3]};
                if (PH == 1) { *(LAS u32x4*)(grL + ctok * 64 + 16 * ccg) = gin[0]; *(LAS u32x4*)(grL + ctok * 64 + 16 * ccg + 8) = gin[1]; }
            }
            if (st + 1 < NT) SW_LOAD(st + 1);
            __syncthreads();
            float av[16], bv[16];
            {
                f32x16 accR = f32x16{}, accI = f32x16{};
#pragma unroll
                for (int s = 0; s < 4; ++s) { const LAS float* xp = xcf + (tt * 32 + r32) * 68 + 16 * s + 8 * hi; const f32x4 p0 = *(const LAS f32x4*)xp, p1 = *(const LAS f32x4*)(xp + 4);
                    float t8[8] = {p0.x, p0.y, p0.z, p0.w, p1.x, p1.y, p1.z, p1.w}; const bf16x8 af = pack8(t8);
                    const bf16x8 wrf = __builtin_bit_cast(bf16x8, wL[((0 * 2 + ct) * 4 + s) * 64 + lane]), wif = __builtin_bit_cast(bf16x8, wL[((1 * 2 + ct) * 4 + s) * 64 + lane]);
                    accR = __builtin_amdgcn_mfma_f32_32x32x16_bf16(af, wrf, accR, 0, 0, 0); accI = __builtin_amdgcn_mfma_f32_32x32x16_bf16(af, wif, accI, 0, 0, 0); }
#define LRU_GATE_LOOP(FALLBACK) _Pragma("unroll") for (int r = 0; r < 16; ++r) { const int tau = tt * 32 + crow(r, hi); \
                    const float rg = __builtin_amdgcn_rcpf(1.0f + __builtin_amdgcn_exp2f(__builtin_fmaf(accR[r], -LOG2E, nr))), ig = __builtin_amdgcn_rcpf(1.0f + __builtin_amdgcn_exp2f(__builtin_fmaf(accI[r], -LOG2E, ni))), xv = xcf[tau * 68 + jch]; \
                    const float log_a = cc8 * rg; av[r] = __builtin_amdgcn_exp2f(log_a * LOG2E); \
                    const float x2 = 2.0f * log_a; \
                    float om = -x2 * (1.0f + x2 * (0.5f + x2 * (0.16666667f + x2 * (0.041666668f + x2 * 0.008333334f)))); \
                    if (FALLBACK) { if (x2 <= -0.25f) om = 1.0f - __builtin_amdgcn_exp2f(x2 * LOG2E); } \
                    bv[r] = __builtin_amdgcn_sqrtf(om) * ig * xv; }
                if (__builtin_expect(__any(-2.0f * cc8 >= 0.25f), 0)) { LRU_GATE_LOOP(true) } else { LRU_GATE_LOOP(false) }
#undef LRU_GATE_LOOP
            }
            float hs[16];
            if (PH == 1) {
#pragma unroll
                for (int r = 0; r < 16; ++r) hs[r] = HS[(rowbase + t0 + tt * 32 + crow(r, hi)) * 512 + chj];
            }
#define SW_SCAN(DIR_) do { \
            float QA[8], QB[8]; \
            { \
                float qa[4], qb[4]; \
            _Pragma("unroll") \
                for (int g = 0; g < 4; ++g) { float A = 1.f, Bq = 0.f; \
            _Pragma("unroll") \
                    for (int ee = 0; ee < 4; ++ee) { const int r = 4 * g + (DIR_ ? 3 - ee : ee); Bq = av[r] * Bq + bv[r]; A *= av[r]; } \
                    qa[g] = A; qb[g] = Bq; } \
            _Pragma("unroll") \
                for (int g = 0; g < 4; ++g) { const float pa = __shfl_xor(qa[g], 32), pb = __shfl_xor(qb[g], 32); \
                    QA[2 * g] = hi ? pa : qa[g]; QA[2 * g + 1] = hi ? qa[g] : pa; QB[2 * g] = hi ? pb : qb[g]; QB[2 * g + 1] = hi ? qb[g] : pb; } \
            } \
            { \
                float AW = 1.f, BW = 0.f; \
            _Pragma("unroll") \
                for (int qq = 0; qq < 8; ++qq) { const int q = DIR_ ? 7 - qq : qq; BW = QA[q] * BW + QB[q]; AW *= QA[q]; } \
                if (hi == 0) { wtA[tt * 64 + jch] = AW; wtB[tt * 64 + jch] = BW; } \
            } \
            __syncthreads(); \
            { \
                float h = carry[(st & 1) * 64 + jch]; \
            _Pragma("unroll") \
                for (int ww = 0; ww < 4; ++ww) { const int w = DIR_ ? 3 - ww : ww; const float sa = wtA[w * 64 + jch], sb = wtB[w * 64 + jch]; \
                    if (DIR_ ? (w > tt) : (w < tt)) h = sa * h + sb; } \
                float hin[4] = {0.f, 0.f, 0.f, 0.f}; \
            _Pragma("unroll") \
                for (int qq = 0; qq < 8; ++qq) { const int q = DIR_ ? 7 - qq : qq; hin[q >> 1] = ((q & 1) == hi) ? h : hin[q >> 1]; h = QA[q] * h + QB[q]; } \
                if (tt == (DIR_ ? 0 : 3) && hi == 0) { \
                    carry[((st + 1) & 1) * 64 + jch] = h; \
                    if (PH == 0 && st == NT - 1) XC[((size_t)((b * 8 + n) * 2 + dir)) * 64 + jch] = h; \
                } \
                if (!isctx) { \
            _Pragma("unroll") \
                    for (int g = 0; g < 4; ++g) { float hc = hin[g]; \
            _Pragma("unroll") \
                        for (int ee = 0; ee < 4; ++ee) { const int r = 4 * g + (DIR_ ? 3 - ee : ee); hc = av[r] * hc + bv[r]; \
                            const int tau = tt * 32 + crow(r, hi); \
                            if (PH == 0) HS[(rowbase + t0 + tau) * 512 + chj] = hc; \
                            else xcf[tau * 68 + jch] = (hs[r] + hc) * gelu_fast(bf1(grL[tau * 64 + jch])); } } \
                } \
            } \
            } while (0)
            if (dir) SW_SCAN(1); else SW_SCAN(0);
#undef SW_SCAN
            if (PH == 1) {
                __syncthreads();
                float o[16];
#pragma unroll
                for (int q = 0; q < 4; ++q) { const f32x4 hv = *(const LAS f32x4*)(xcf + ctok * 68 + 16 * ccg + 4 * q); o[4 * q] = hv.x; o[4 * q + 1] = hv.y; o[4 * q + 2] = hv.z; o[4 * q + 3] = hv.w; }
                bf16_t* op = AO + (rowbase + t0 + ctok) * DM + 512 + ch0;
                *(bf16x8*)op = pack8(o); *(bf16x8*)(op + 8) = pack8(o + 8);
            }
        }
#undef SW_TILE
#undef SW_LOAD
    }
}

__device__ __forceinline__ void phase3a(const Args& a, LAS unsigned char* lds) {
    lru_sweep<0>(a, lds);
    unsigned* ctr = (unsigned*)(a.ws + WS_CTL) + 64;
    LAS int* slot = (LAS int*)(lds + 140000);
    for (;;) {
        __syncthreads();
        if (threadIdx.x == 0) *slot = (int)atomicAdd(ctr, 1u);
        __syncthreads();
        const int it = *slot;
        if (it >= 1024) break;
#ifndef NO_ATTN
        attn_unit(a, lds, it);
#endif
    }
    if (gridDim.x == 256) {
        constexpr int QN = (N_ITEMS_ALL - N_DEFER - N_ITEMS_P0) / 16;
        static_assert((N_ITEMS_ALL - N_DEFER - N_ITEMS_P0) % 16 == 0, "weight-copy queue granularity");
        const int lane = threadIdx.x & 63, wid = threadIdx.x >> 6;
        LAS float* scr = (LAS float*)(lds + wid * 16896);
        for (;;) {
            __syncthreads();
            if (threadIdx.x == 0) *slot = (int)atomicAdd(ctr + 128, 1u);
            __syncthreads();
            const int g = *slot;
            if (g >= QN) break;
            const int it0 = N_ITEMS_P0 + g * 16 + wid * 2;
            const TItem t0 = decode_item(a, a.ws, it0); const TItem t1 = decode_item(a, a.ws, it0 + 1);
            transpose_pair(t0, t1, true, scr, lane);
        }
    }
}
__device__ __forceinline__ void phase3b(const Args& a, LAS unsigned char* lds) {
    lru_sweep<1>(a, lds);
}

__device__ __forceinline__ void phase5(const Args& a, LAS unsigned char* lds) {
    const int tid = threadIdx.x, lane = tid & 63, wid = __builtin_amdgcn_readfirstlane(tid >> 6);
    LAS u32x4* WH = (LAS u32x4*)lds;
    LAS u32x4* WLo = (LAS u32x4*)(lds + 32768);
    LAS float* cL = (LAS float*)(lds + 65536);
    const float* mod = (const float*)(a.ws + WS_MOD); bf16_t* H2 = (bf16_t*)(a.ws + WS_H); float* aff = (float*)(a.ws + WS_AFF);
    const float* wr = a.in[I_WROUTER];
    for (int blk = blockIdx.x; blk < ML / 256; blk += gridDim.x) {
        const int b = blk >> 4, row0 = blk * 256;
        const float* sh2 = mod + b * 6144 + 3072; const float* sc2 = mod + b * 6144 + 4096;
        __syncthreads();
        for (int idx = tid; idx < 2048; idx += NTHREADS) {
            const int e = idx & 15, kq = (idx >> 4) & 3, ks = idx >> 6, k0 = 32 * ks + 8 * kq;
            float w[8], wl[8];
#pragma unroll
            for (int j = 0; j < 8; ++j) { const int d = k0 + j; w[j] = a.in[I_N2G][d] * (1.0f + sc2[d]) * wr[d * 16 + e]; }
            u32x4 hi; hi.x = pk2(w[0], w[1]); hi.y = pk2(w[2], w[3]); hi.z = pk2(w[4], w[5]); hi.w = pk2(w[6], w[7]);
            float wh[8]; unpack8(hi, wh);
#pragma unroll
            for (int j = 0; j < 8; ++j) wl[j] = w[j] - wh[j];
            u32x4 lo; lo.x = pk2(wl[0], wl[1]); lo.y = pk2(wl[2], wl[3]); lo.z = pk2(wl[4], wl[5]); lo.w = pk2(wl[6], wl[7]);
            WH[idx] = hi; WLo[idx] = lo;
        }
        if (wid == 0) {
            float ce[16];
#pragma unroll
            for (int e = 0; e < 16; ++e) ce[e] = 0.f;
            for (int i = 0; i < 16; ++i) { const int d = lane + 64 * i; const float sv = sh2[d];
#pragma unroll
                for (int e = 0; e < 16; ++e) ce[e] += sv * wr[d * 16 + e]; }
#pragma unroll
            for (int e = 0; e < 16; ++e) { const float t = wave_sum(ce[e]); if (lane == e) cL[e] = t; }
        }
        f32x4 gs[4], shv[4];
#pragma unroll
        for (int j = 0; j < 4; ++j) { const f32x4 g = *((const f32x4*)a.in[I_N2G] + lane + 64 * j), sc = *((const f32x4*)sc2 + lane + 64 * j); gs[j] = g * (sc + 1.0f); shv[j] = *((const f32x4*)sh2 + lane + 64 * j); }
        __syncthreads();
        const float cmine = cL[lane & 15];
        for (int it = 0; it < 2; ++it) {
            const int r0 = row0 + (wid * 2 + it) * 16;
            const float* xp = a.out + (size_t)(r0 + (lane & 15)) * DM + 8 * (lane >> 4);
            f32x4 acc = (f32x4){0.f, 0.f, 0.f, 0.f}; float ssq = 0.f;
#pragma unroll 1
            for (int kb = 0; kb < 4; ++kb) {
                f32x4 v[8][2];
#pragma unroll
                for (int i = 0; i < 8; ++i) { v[i][0] = *(const f32x4*)(xp + 32 * (kb * 8 + i)); v[i][1] = *(const f32x4*)(xp + 32 * (kb * 8 + i) + 4); }
#pragma unroll
                for (int i = 0; i < 8; ++i) {
                    const int ks = kb * 8 + i;
                    const float x[8] = {v[i][0].x, v[i][0].y, v[i][0].z, v[i][0].w, v[i][1].x, v[i][1].y, v[i][1].z, v[i][1].w};
#pragma unroll
                    for (int j = 0; j < 8; ++j) ssq += x[j] * x[j];
                    u32x4 hi; hi.x = pk2(x[0], x[1]); hi.y = pk2(x[2], x[3]); hi.z = pk2(x[4], x[5]); hi.w = pk2(x[6], x[7]);
                    float xh[8], xl[8]; unpack8(hi, xh);
#pragma unroll
                    for (int j = 0; j < 8; ++j) xl[j] = x[j] - xh[j];
                    u32x4 lo; lo.x = pk2(xl[0], xl[1]); lo.y = pk2(xl[2], xl[3]); lo.z = pk2(xl[4], xl[5]); lo.w = pk2(xl[6], xl[7]);
                    const bf16x8 ah = __builtin_bit_cast(bf16x8, hi), al = __builtin_bit_cast(bf16x8, lo);
                    const bf16x8 bh = __builtin_bit_cast(bf16x8, WH[ks * 64 + lane]), bl = __builtin_bit_cast(bf16x8, WLo[ks * 64 + lane]);
                    acc = __builtin_amdgcn_mfma_f32_16x16x32_bf16(ah, bh, acc, 0, 0, 0);
                    acc = __builtin_amdgcn_mfma_f32_16x16x32_bf16(al, bh, acc, 0, 0, 0);
                    acc = __builtin_amdgcn_mfma_f32_16x16x32_bf16(ah, bl, acc, 0, 0, 0);
                }
            }
            ssq += __shfl_xor(ssq, 16); ssq += __shfl_xor(ssq, 32);
            const float rstd_l = rsqrtf(ssq * (1.0f / DM) + EPSN);
#pragma unroll
            for (int rg = 0; rg < 4; ++rg) {
                const int row = 4 * (lane >> 4) + rg;
                const float rs = __shfl(rstd_l, row);
                const float lg = acc[rg] * rs + cmine;
                float mx = lg; mx = fmaxf(mx, __shfl_xor(mx, 1)); mx = fmaxf(mx, __shfl_xor(mx, 2)); mx = fmaxf(mx, __shfl_xor(mx, 4)); mx = fmaxf(mx, __shfl_xor(mx, 8));
                const float ex = expf(lg - mx);
                float sm = ex; sm += __shfl_xor(sm, 1); sm += __shfl_xor(sm, 2); sm += __shfl_xor(sm, 4); sm += __shfl_xor(sm, 8);
                const int t = (r0 + row) & 4095;
                aff[((size_t)(b * 16 + (lane & 15))) * SEQL + t] = ex / sm;
            }
#pragma unroll 1
            for (int rr = 0; rr < 16; rr += 4) {
                f32x4 hv[4][4];
#pragma unroll
                for (int q = 0; q < 4; ++q) load_row(a.out + (size_t)(r0 + rr + q) * DM, lane, hv[q]);
#pragma unroll
                for (int q = 0; q < 4; ++q) { const float rs = __shfl(rstd_l, rr + q);
#pragma unroll
                    for (int j = 0; j < 4; ++j) { const f32x4 o = (hv[q][j] * rs) * gs[j] + shv[j]; u32x2 w2; w2.x = pk2(o.x, o.y); w2.y = pk2(o.z, o.w); *((u32x2*)(H2 + (size_t)(r0 + rr + q) * DM) + lane + 64 * j) = w2; } }
            }
        }
    }
}

__device__ __forceinline__ void phase6(const Args& a, LAS unsigned char* lds) {
    const int tid = threadIdx.x, lane = tid & 63, wid = tid >> 6;
    LAS unsigned* hist = (LAS unsigned*)lds;
    LAS unsigned* selw = (LAS unsigned*)(lds + 1024);
    LAS unsigned* wtot = (LAS unsigned*)(lds + 1088);
    LAS int* selL = (LAS int*)(lds + 2048);
    const float* aff = (const float*)(a.ws + WS_AFF); const bf16_t* H2 = (const bf16_t*)(a.ws + WS_H);
    int* idx = (int*)(a.ws + WS_IDX); float* gv = (float*)(a.ws + WS_GV); bf16_t* XS = (bf16_t*)(a.ws + WS_XS); int* slotOf = (int*)(a.ws + WS_SLOT);
    for (int item = blockIdx.x; item < NB * NE; item += gridDim.x) {
        const int b = item >> 4;
        const float* ap = aff + (size_t)item * SEQL + tid * 8;
        const f32x4 f0 = *(const f32x4*)ap, f1 = *(const f32x4*)(ap + 4);
        const float fv[8] = {f0.x, f0.y, f0.z, f0.w, f1.x, f1.y, f1.z, f1.w};
        unsigned u[8];
#pragma unroll
        for (int i = 0; i < 8; ++i) u[i] = __builtin_bit_cast(unsigned, fv[i]);
        unsigned prefix = 0, mask = 0, remaining = CAP;
        for (int pass = 0; pass < 4; ++pass) {
            const int shift = 24 - 8 * pass;
            if (tid < 256) hist[tid] = 0;
            __syncthreads();
#pragma unroll
            for (int i = 0; i < 8; ++i) if ((u[i] & mask) == prefix) atomicAdd((unsigned*)&hist[(u[i] >> shift) & 255], 1u);
            __syncthreads();
            if (wid == 0) {
                unsigned c4[4]; unsigned s = 0;
#pragma unroll
                for (int j = 0; j < 4; ++j) { c4[j] = hist[255 - (4 * lane + j)]; s += c4[j]; }
                unsigned incl = s;
#pragma unroll
                for (int o = 1; o < 64; o <<= 1) { const unsigned t = __shfl_up(incl, o); if (lane >= o) incl += t; }
                const unsigned excl = incl - s;
                if (excl < remaining && remaining <= incl) {
                    unsigned run = excl; int jb = 0; unsigned rem = 0; bool found = false;
#pragma unroll
                    for (int j = 0; j < 4; ++j) { if (!found && run + c4[j] >= remaining) { jb = j; rem = remaining - run; found = true; } if (!found) run += c4[j]; }
                    selw[0] = 255 - (4 * lane + jb); selw[1] = rem;
                }
            }
            __syncthreads();
            prefix |= selw[0] << shift; mask |= 255u << shift; remaining = selw[1];
            __syncthreads();
        }
        const unsigned T = prefix;
        unsigned cg_ = 0, ce = 0;
#pragma unroll
        for (int i = 0; i < 8; ++i) { cg_ += (u[i] > T); ce += (u[i] == T); }
        const unsigned packed = cg_ | (ce << 16);
        unsigned incl = packed;
#pragma unroll
        for (int o = 1; o < 64; o <<= 1) { const unsigned t = __shfl_up(incl, o); if (lane >= o) incl += t; }
        if (lane == 63) wtot[wid] = incl;
        __syncthreads();
        unsigned base = 0;
        for (int w = 0; w < wid; ++w) base += wtot[w];
        const unsigned excl = base + incl - packed;
        unsigned gB = excl & 0xffffu, eB = excl >> 16;
#pragma unroll
        for (int i = 0; i < 8; ++i) {
            const int t = tid * 8 + i; int pos = -1;
            if (u[i] > T) { pos = (int)(gB + (eB < remaining ? eB : remaining)); ++gB; }
            else if (u[i] == T) { if (eB < remaining) pos = (int)(gB + eB); ++eB; }
            if (pos >= 0) { idx[(size_t)item * CAP + pos] = b * SEQL + t; gv[(size_t)item * CAP + pos] = fv[i]; }
            slotOf[(size_t)item * SEQL + t] = pos;
        }
        __syncthreads();
        __syncthreads();
    }
}

__device__ __forceinline__ void phase9(const Args& a) {
    const int lane = threadIdx.x & 63, wid = threadIdx.x >> 6;
    const int gw = blockIdx.x * NWAVES + wid, NGW = gridDim.x * NWAVES;
    const float* mod = (const float*)(a.ws + WS_MOD); const bf16_t* YS = (const bf16_t*)(a.ws + WS_YS); const int* slotOf = (const int*)(a.ws + WS_SLOT);
    int pn = -1;
    if (gw < ML && lane < 16) pn = slotOf[((size_t)((gw >> 12) * 16 + lane)) * SEQL + (gw & 4095)];
    for (int m = gw; m < ML; m += NGW) {
        const int b = m >> 12;
        const int myp = pn; pn = -1;
        { const int mn = m + NGW; if (mn < ML && lane < 16) pn = slotOf[((size_t)((mn >> 12) * 16 + lane)) * SEQL + (mn & 4095)]; }
        float* op = a.out + (size_t)m * DM + 8 * lane; const float* g2 = mod + b * 6144 + 5120 + 8 * lane;
        f32x4 xv[2][2], gg[2][2];
#pragma unroll
        for (int j = 0; j < 2; ++j)
#pragma unroll
            for (int q = 0; q < 2; ++q) { xv[j][q] = *(const f32x4*)(op + 512 * j + 4 * q); gg[j][q] = *(const f32x4*)(g2 + 512 * j + 4 * q); }
        float acc[2][8];
#pragma unroll
        for (int j = 0; j < 2; ++j)
#pragma unroll
            for (int i = 0; i < 8; ++i) acc[j][i] = 0.f;
        unsigned long long msk = __ballot(myp >= 0);
        while (msk) {
            const int e0 = __builtin_ctzll(msk); msk &= msk - 1;
            const bool two = msk != 0; const int e1 = two ? __builtin_ctzll(msk) : e0; if (two) msk &= msk - 1;
            const int p0 = __shfl(myp, e0), p1 = __shfl(myp, e1);
            const bf16_t* y0 = YS + ((size_t)(b * 16 + e0) * CAP + p0) * DM + 8 * lane; const bf16_t* y1 = YS + ((size_t)(b * 16 + e1) * CAP + p1) * DM + 8 * lane;
            const u32x4 r00 = *(const u32x4*)y0, r01 = *(const u32x4*)(y0 + 512), r10 = *(const u32x4*)y1, r11 = *(const u32x4*)(y1 + 512);
            const float w1 = two ? 1.f : 0.f;
            float t0[8], t1[8];
            unpack8(r00, t0); unpack8(r10, t1);
#pragma unroll
            for (int i = 0; i < 8; ++i) acc[0][i] += t0[i] + w1 * t1[i];
            unpack8(r01, t0); unpack8(r11, t1);
#pragma unroll
            for (int i = 0; i < 8; ++i) acc[1][i] += t0[i] + w1 * t1[i];
        }
#pragma unroll
        for (int j = 0; j < 2; ++j)
#pragma unroll
            for (int q = 0; q < 2; ++q) { const f32x4 av = (f32x4){acc[j][4 * q], acc[j][4 * q + 1], acc[j][4 * q + 2], acc[j][4 * q + 3]};
                *(f32x4*)(op + 512 * j + 4 * q) = xv[j][q] + gg[j][q] * av; }
    }
}


#define XB_TMO      128
#define XB_XCNT(j)  (256  + 64 * (j))
#define XB_XSUB(j)  (1280 + 64 * (j))
#define XB_XGEN(j)  (2304 + 64 * (j))
#define XB_TOP      3328
#define XB_TOPGEN   3392
#define XCD_BAR_WORDS 3456
#define XB_SPIN_CAP (1u << 18)
__device__ __forceinline__ unsigned xb_ld(unsigned* p)              { return __hip_atomic_load(p, __ATOMIC_RELAXED, __HIP_MEMORY_SCOPE_AGENT); }
__device__ __forceinline__ unsigned xb_add(unsigned* p, unsigned v) { return __hip_atomic_fetch_add(p, v, __ATOMIC_RELAXED, __HIP_MEMORY_SCOPE_AGENT); }
__device__ __forceinline__ unsigned xb_xcc_id() { return (unsigned)__builtin_amdgcn_s_getreg((3 << 11) | 20) & 0xFu; }
#define XB_SPIN(cond, bar) do { unsigned _sp = 0; while (cond) { __builtin_amdgcn_s_sleep(1); \
    if ((++_sp & 255u) == 0u) { if (xb_ld(&(bar)[XB_TMO])) break; if (_sp > XB_SPIN_CAP) { atomicAdd(&(bar)[XB_TMO], 1u); break; } } } } while (0)
struct XcdBarrier { unsigned* bar; unsigned x; volatile LAS unsigned* st; };
__device__ __forceinline__ XcdBarrier xcd_barrier_post(unsigned* bar, volatile LAS unsigned* st) {
    XcdBarrier b; b.bar = bar; b.x = xb_xcc_id(); b.st = st;
    if (threadIdx.x == 0) (void)xb_add(&bar[XB_XCNT(b.x)], 1u);
    return b;
}
__device__ __forceinline__ void xcd_barrier_complete(unsigned* bar, unsigned x, unsigned& nloc, unsigned& nx) {
    const unsigned G = gridDim.x * gridDim.y * gridDim.z;
    unsigned sum, cnt, mine, sp = 0u;
    for (;;) {
        sum = 0u; cnt = 0u; mine = 0u;
#pragma unroll
        for (unsigned j = 0; j < 16; ++j) { const unsigned c = xb_ld(&bar[XB_XCNT(j)]); sum += c; cnt += (c > 0u) ? 1u : 0u; mine = (j == x) ? c : mine; }
        if (sum == G) break;
        __builtin_amdgcn_s_sleep(1);
        if ((++sp & 255u) == 0u) { if (xb_ld(&bar[XB_TMO])) break; if (sp > XB_SPIN_CAP) { atomicAdd(&bar[XB_TMO], 1u); break; } }
    }
    nloc = mine > 0u ? mine : 1u; nx = cnt > 0u ? cnt : 1u;
}
__device__ __forceinline__ void xcd_barrier(const XcdBarrier& b) {
    asm volatile("s_waitcnt vmcnt(0)" ::: "memory");
    __syncthreads();
    if (threadIdx.x == 0) {
        unsigned* bar = b.bar;
        __builtin_amdgcn_s_waitcnt(0);
        unsigned nloc = b.st[0], nx = b.st[1];
        if (nloc == 0u) { xcd_barrier_complete(bar, b.x, nloc, nx); b.st[0] = nloc; b.st[1] = nx; }
        const unsigned old = xb_add(&bar[XB_XSUB(b.x)], 1u);
        const unsigned gen = old / nloc;
        if (old + 1u == (gen + 1u) * nloc) {
            __builtin_amdgcn_fence(__ATOMIC_RELEASE, "agent");
            asm volatile("s_waitcnt vmcnt(0)" ::: "memory");
            const unsigned og = xb_add(&bar[XB_TOP], 1u);
            const unsigned tg = og / nx;
            if (og + 1u == (tg + 1u) * nx) xb_add(&bar[XB_TOPGEN], 1u);
            else XB_SPIN(xb_ld(&bar[XB_TOPGEN]) == tg, bar);
            __builtin_amdgcn_fence(__ATOMIC_ACQUIRE, "agent");
            xb_add(&bar[XB_XGEN(b.x)], 1u);
            asm volatile("s_waitcnt vmcnt(0)" ::: "memory");
        } else {
            XB_SPIN(xb_ld(&bar[XB_XGEN(b.x)]) == gen, bar);
            __builtin_amdgcn_fence(__ATOMIC_ACQUIRE, "agent");
            asm volatile("s_waitcnt vmcnt(0)" ::: "memory");
        }
    }
    __syncthreads();
}

constexpr int NPHASE = 10;
__global__ void __launch_bounds__(NTHREADS, 2) fwd_kernel(Args args) {
    extern __shared__ __attribute__((aligned(16))) unsigned char lds_raw[];
    LAS unsigned char* lds = (LAS unsigned char*)lds_raw;
    cg::grid_group grid = cg::this_grid();
    const int lo = args.ph_lo, hi = args.ph_hi;
    unsigned char* ws = args.ws;
#ifdef ONLY_PHASE
#define IN(k) ((k)==ONLY_PHASE && lo <= (k) && (k) < hi)
#else
#define IN(k) (lo <= (k) && (k) < hi)
#endif
    { LAS unsigned* st0 = (LAS unsigned*)(lds + 147328); if (threadIdx.x < 2) st0[threadIdx.x] = 0u; __syncthreads(); }
    const XcdBarrier xbar = xcd_barrier_post((unsigned*)(ws + WS_CTL) + 4096, (volatile LAS unsigned*)(lds + 147328));
    if (args.ph_hi < 0) grid.sync();
#define SEAM(k) do { if (IN(k) && IN((k) + 1)) xcd_barrier(xbar); } while (0)
#ifndef REPEAT_MASK
#define REPEAT_MASK 0
#endif
#define REP(k, body) do { if ((REPEAT_MASK >> (k)) & 1) { grid.sync(); body; } } while (0)
    if (IN(0)) { phase0(args, lds); REP(0, phase0(args, lds)); } SEAM(0);
    if (IN(1)) { phase1(args); REP(1, phase1(args)); } SEAM(1);
    if (IN(2)) {
        pg8::Gemm g{(const bf16_t*)(ws + WS_H), (const bf16_t*)(ws + WS_WIN), MT, NIN, DM, nullptr}; pg8::Order S; S.init(MT, NIN, gridDim.x, blockIdx.x, 0, 0);
        pg8::EpiStoreBf16 E{(bf16_t*)(ws + WS_QKV), NIN, nullptr};
        pg8::gemm_phase<pg8::EpiStoreBf16>(lds, g, S, E);
        deferred_weight_copies(args, lds);
    } SEAM(2);
    if (IN(3)) { phase3a(args, lds); xcd_barrier(xbar); phase3b(args, lds); } SEAM(3);
    if (IN(4)) {
        pg8::Gemm g{(const bf16_t*)(ws + WS_AO), (const bf16_t*)(ws + WS_WOUT), ML, DM, DM, nullptr}; pg8::Order S; S.init(ML, DM, gridDim.x, blockIdx.x, 0, 0);
        pg8::EpiResid E{args.in[I_X], args.out, (const float*)(ws + WS_MOD) + 2048};
        pg8::gemm_phase<pg8::EpiResid>(lds, g, S, E);
        REP(4, pg8::gemm_phase<pg8::EpiResid>(lds, g, S, E));
    } SEAM(4);
    if (IN(5)) { phase5(args, lds); REP(5, phase5(args, lds)); } SEAM(5);
    if (IN(6)) { phase6(args, lds); REP(6, phase6(args, lds)); } SEAM(6);
    if (IN(7)) {
        pg8::Gemm g{(const bf16_t*)(ws + WS_H), (const bf16_t*)(ws + WS_WUP), MX, 2048, DM, (const int*)(ws + WS_IDX)};   pg8::Order S; S.init(MX, 2048, gridDim.x, blockIdx.x, 1, (size_t)2048 * DM * 2);
        pg8::EpiSwiGLU E{(bf16_t*)(ws + WS_HID)};
        pg8::gemm_phase<pg8::EpiSwiGLU, true, true>(lds, g, S, E);
    } SEAM(7);
    if (IN(8)) {
        pg8::Gemm g{(const bf16_t*)(ws + WS_HID), (const bf16_t*)(ws + WS_WDN), MX, DM, DM, nullptr}; pg8::Order S; S.init(MX, DM, gridDim.x, blockIdx.x, 1, (size_t)DM * DM * 2);
        pg8::EpiStoreBf16 E{(bf16_t*)(ws + WS_YS), DM, (const float*)(ws + WS_GV)};
        pg8::gemm_phase<pg8::EpiStoreBf16>(lds, g, S, E);
        REP(8, pg8::gemm_phase<pg8::EpiStoreBf16>(lds, g, S, E));
    } SEAM(8);
    if (IN(9)) { phase9(args); }
#undef IN
#undef SEAM
}

#ifndef MK_PER_PHASE
#define MK_PER_PHASE 0
#endif
extern "C" void kernel_launch(void* const* d_in, const int* in_sizes, int n_in, void* d_out, int out_size, void* d_ws, size_t ws_size, hipStream_t stream) {
    static int grid = 0;
    if (grid == 0) {
        if (n_in != 24 || out_size != ML * DM || ws_size < WS_END) { fprintf(stderr, "kernel_launch: unexpected shapes (n_in %d out %d ws %zu)\n", n_in, out_size, ws_size); grid = -1; return; }
        int dev = 0, cus = 0, per_cu = 0;
        hipGetDevice(&dev); hipDeviceGetAttribute(&cus, hipDeviceAttributeMultiprocessorCount, dev);
        if (hipFuncSetAttribute((const void*)fwd_kernel, hipFuncAttributeMaxDynamicSharedMemorySize, LDS_BYTES) != hipSuccess) { fprintf(stderr, "kernel_launch: hipFuncSetAttribute failed\n"); grid = -1; return; }
        hipOccupancyMaxActiveBlocksPerMultiprocessor(&per_cu, (const void*)fwd_kernel, NTHREADS, LDS_BYTES);
        (void)hipGetLastError();
        if (per_cu < 1) per_cu = 1;
        grid = cus;
        fprintf(stderr, "kernel_launch: grid %d (occupancy query %d/CU)\n", grid, per_cu);
    }
    if (grid < 0) return;
    hipMemsetAsync((char*)d_ws + WS_CTL, 0, 65536, stream);
    Args a{};
    for (int i = 0; i < 24; ++i) a.in[i] = (const float*)d_in[i];
    a.out = (float*)d_out; a.ws = (unsigned char*)d_ws;
#if MK_PER_PHASE
    for (int p = 0; p < NPHASE; ++p) {
        a.ph_lo = p; a.ph_hi = p + 1;
        void* kargs[] = {&a};
        hipError_t e = hipLaunchCooperativeKernel((const void*)fwd_kernel, dim3(grid), dim3(NTHREADS), kargs, LDS_BYTES, stream);
        if (e != hipSuccess) { fprintf(stderr, "kernel_launch: launch of phase %d failed: %s\n", p, hipGetErrorString(e)); break; }
    }
#else
    a.ph_lo = 0; a.ph_hi = NPHASE;
    void* kargs[] = {&a};
    hipError_t e = hipLaunchCooperativeKernel((const void*)fwd_kernel, dim3(grid), dim3(NTHREADS), kargs, LDS_BYTES, stream);
    if (e != hipSuccess) fprintf(stderr, "kernel_launch: cooperative launch failed: %s (grid %d)\n", hipGetErrorString(e), grid);
#endif
}
```

```cpp
#include <hip/hip_runtime.h>
#include <hip/hip_cooperative_groups.h>
#include <cstdio>
#include <cstdint>
namespace cg = cooperative_groups;

#define LAS __attribute__((address_space(3)))
typedef unsigned short bf16_t;
typedef short bf16x8 __attribute__((ext_vector_type(8)));
typedef short s16x4 __attribute__((ext_vector_type(4)));
typedef float f32x4 __attribute__((ext_vector_type(4)));
typedef float f32x16 __attribute__((ext_vector_type(16)));
typedef unsigned u32x4 __attribute__((ext_vector_type(4)));
typedef unsigned u32x2 __attribute__((ext_vector_type(2)));

constexpr int NB = 16, SEQL = 4096, DM = 1024, LCTX = 256, NIN = 1792;
constexpr int ML = NB * SEQL, MC = NB * LCTX, MT = ML + MC;
constexpr int NE = 16, CAP = 512, MX = NB * NE * CAP;
constexpr int NTHREADS = 512, NWAVES = 8;
constexpr float EPSN = 1e-6f;
constexpr float LOG2E = 1.4426950408889634f;

constexpr size_t MiB = 1u << 20;
constexpr size_t WS_CTL = 0, WS_MOD = 1 * MiB, WS_WIN = 2 * MiB, WS_WOUT = 6 * MiB, WS_WUP = 8 * MiB, WS_WDN = 72 * MiB, WS_AFF = 104 * MiB,
                 WS_IDX = 108 * MiB, WS_GV = 109 * MiB, WS_H = 110 * MiB, WS_QKV = 246 * MiB, WS_AO = 484 * MiB, WS_XS = 612 * MiB, WS_HF = 868 * MiB,
                 WS_SLOT = 996 * MiB, WS_END = 1000 * MiB;
constexpr size_t WS_HID = WS_QKV;
constexpr size_t WS_YS = WS_XS;
constexpr size_t WS_AGG = WS_HF;
constexpr size_t WS_LW = WS_MOD + 512 * 1024;
constexpr int LDS_BYTES = 147456;

__device__ __forceinline__ unsigned f2bf(float f) { unsigned u = __builtin_bit_cast(unsigned, f); return (u + 0x7fffu + ((u >> 16) & 1u)) >> 16; }
__device__ __forceinline__ unsigned pk2(float lo, float hi) { unsigned r; asm("v_cvt_pk_bf16_f32 %0, %1, %2" : "=v"(r) : "v"(lo), "v"(hi)); return r; }
__device__ __forceinline__ float bflo(unsigned u) { return __builtin_bit_cast(float, u << 16); }
__device__ __forceinline__ float bfhi(unsigned u) { return __builtin_bit_cast(float, u & 0xffff0000u); }
__device__ __forceinline__ float bf1(bf16_t h) { return __builtin_bit_cast(float, ((unsigned)h) << 16); }
__device__ __forceinline__ void unpack8(u32x4 r, float* o) { o[0] = bflo(r.x); o[1] = bfhi(r.x); o[2] = bflo(r.y); o[3] = bfhi(r.y); o[4] = bflo(r.z); o[5] = bfhi(r.z); o[6] = bflo(r.w); o[7] = bfhi(r.w); }
__device__ __forceinline__ bf16x8 pack8(const float* v) { u32x4 w; w.x = pk2(v[0], v[1]); w.y = pk2(v[2], v[3]); w.z = pk2(v[4], v[5]); w.w = pk2(v[6], v[7]); return __builtin_bit_cast(bf16x8, w); }
__device__ __forceinline__ float wave_sum(float v) {
#pragma unroll
    for (int o = 1; o < 64; o <<= 1) v += __shfl_xor(v, o);
    return v;
}
__device__ __forceinline__ int crow(int r, int hi) { return (r & 3) + 8 * (r >> 2) + 4 * hi; }
__device__ __forceinline__ float sigmoidf_(float x) { return 1.0f / (1.0f + __expf(-x)); }

namespace pg8 {
#define PG8_LAS __attribute__((address_space(3)))
constexpr int BM = 256, BK = 64, HALF = 128, HTB = HALF * BK * 2, STAGE_BYTES = 8 * HTB, NXCD = 8, WGM = 8;
__host__ __device__ __forceinline__ int lds_byte(int r, int c) { const int st = (r >> 4) * 2 + (c >> 5), rr = r & 15, cc = c & 31, ob = rr * 64 + cc * 2; return st * 1024 + (ob ^ (((ob >> 9) & 1) << 5)); }
__host__ __device__ __forceinline__ void stage_rc(int b, int& R, int& C) { const int st = b / 1024, sb = b % 1024, swz = sb ^ (((sb >> 9) & 1) << 5); R = (st >> 1) * 16 + swz / 64; C = (st & 1) * 32 + (swz % 64) / 2; }
__host__ __device__ __forceinline__ int perm32(int rho) { const int n = rho >> 4, i = rho & 15; return 8 * (i >> 2) + 4 * n + (i & 3); }

struct Unit { int pm, pn, e; };
struct Gemm { const bf16_t* A; const bf16_t* Bt; int M, N, K; const int* rowmap; };

struct Order {
    int nM, nN, nwg, G, c, mode; size_t bstride;
    __device__ void init(int M, int N, int G_, int c_, int mode_, size_t bstride_) { nM = M / BM; nN = N / BM; nwg = nM * nN; G = G_; c = c_; mode = mode_; bstride = bstride_; }
    __device__ bool next(int i, Unit& u) const {
        const long Lq = (long)i * G + c; if (Lq >= nwg) return false;
        int wgid = (int)Lq; { const int q = nwg / NXCD, r = nwg % NXCD, xcd = wgid % NXCD, off = wgid / NXCD; wgid = (xcd < r ? xcd * (q + 1) : r * (q + 1) + (xcd - r) * q) + off; }
        const int nig = WGM * nN, gid = wgid / nig, fm = gid * WGM, gsz = (nM - fm) < WGM ? (nM - fm) : WGM;
        int pm = fm + ((wgid % nig) % gsz); u.pn = (wgid % nig) / gsz; u.e = 0;
        if (mode == 1) { const int e = pm >> 5, b = (pm >> 1) & 15, hf = pm & 1; pm = (b * 16 + e) * 2 + hf; u.e = e; }
        u.pm = pm; return true;
    }
};

__device__ __forceinline__ unsigned cvt_pk_bf16(float lo, float hi) { unsigned r; asm volatile("v_cvt_pk_bf16_f32 %0, %1, %2" : "=v"(r) : "v"(lo), "v"(hi)); return r; }

struct EpiStoreBf16 {
    static constexpr bool PERM = true;
    bf16_t* O; int ldc; const float* rs;
    __device__ __forceinline__ void operator()(const f32x4 (&acc)[2][2][4][2], const Unit& u, int wr, int wc, int fr, int fq) const {
        const int row0 = u.pm * BM + wr * 64 + fr, col0 = u.pn * BM + wc * 32 + 8 * fq;
#pragma unroll
        for (int ai = 0; ai < 2; ++ai)
#pragma unroll
            for (int m = 0; m < 4; ++m) { const int r = row0 + ai * HALF + m * 16; const float s = rs ? rs[r] : 1.0f; bf16_t* rowp = O + (size_t)r * ldc + col0;
#pragma unroll
                for (int bj = 0; bj < 2; ++bj) { const f32x4 v0 = acc[ai][bj][m][0] * s, v1 = acc[ai][bj][m][1] * s;
                    u32x4 w; w.x = cvt_pk_bf16(v0[0], v0[1]); w.y = cvt_pk_bf16(v0[2], v0[3]); w.z = cvt_pk_bf16(v1[0], v1[1]); w.w = cvt_pk_bf16(v1[2], v1[3]);
                    *(u32x4*)(rowp + bj * HALF) = w; } }
    }
};
struct EpiResid {
    static constexpr bool PERM = false;
    const float* x; float* out; const float* gate;
    __device__ __forceinline__ void operator()(const f32x4 (&acc)[2][2][4][2], const Unit& u, int wr, int wc, int fr, int fq) const {
        const int row0 = u.pm * BM + wr * 64 + fr, col0 = u.pn * BM + wc * 32 + 4 * fq; const int b = u.pm >> 4;
        f32x4 gv[2][2];
#pragma unroll
        for (int bj = 0; bj < 2; ++bj)
#pragma unroll
            for (int n = 0; n < 2; ++n) gv[bj][n] = *(const f32x4*)(gate + (size_t)b * 6144 + col0 + bj * HALF + n * 16);
#pragma unroll
        for (int ai = 0; ai < 2; ++ai) {
            f32x4 xv[4][2][2];
#pragma unroll
            for (int m = 0; m < 4; ++m) { const size_t ro = (size_t)(row0 + ai * HALF + m * 16) * DM + col0;
#pragma unroll
                for (int bj = 0; bj < 2; ++bj)
#pragma unroll
                    for (int n = 0; n < 2; ++n) xv[m][bj][n] = *(const f32x4*)(x + ro + bj * HALF + n * 16); }
            __builtin_amdgcn_sched_barrier(0);
#pragma unroll
            for (int m = 0; m < 4; ++m) { const size_t ro = (size_t)(row0 + ai * HALF + m * 16) * DM + col0;
#pragma unroll
                for (int bj = 0; bj < 2; ++bj)
#pragma unroll
                    for (int n = 0; n < 2; ++n) *(f32x4*)(out + ro + bj * HALF + n * 16) = xv[m][bj][n] + gv[bj][n] * acc[ai][bj][m][n]; }
            __builtin_amdgcn_sched_barrier(0);
        }
    }
};
struct EpiSwiGLU {
    static constexpr bool PERM = true;
    bf16_t* O;
    __device__ __forceinline__ void operator()(const f32x4 (&acc)[2][2][4][2], const Unit& u, int wr, int wc, int fr, int fq) const {
        const int row0 = u.pm * BM + wr * 64 + fr, col0 = u.pn * HALF + wc * 32 + 8 * fq;
#pragma unroll
        for (int ai = 0; ai < 2; ++ai)
#pragma unroll
            for (int m = 0; m < 4; ++m) { bf16_t* rowp = O + (size_t)(row0 + ai * HALF + m * 16) * DM + col0; float h[8];
#pragma unroll
                for (int n = 0; n < 2; ++n)
#pragma unroll
                    for (int j = 0; j < 4; ++j) { const float g = acc[ai][0][m][n][j], up = acc[ai][1][m][n][j]; h[n * 4 + j] = g * __builtin_amdgcn_rcpf(1.0f + __expf(-g)) * up; }
                u32x4 w; w.x = cvt_pk_bf16(h[0], h[1]); w.y = cvt_pk_bf16(h[2], h[3]); w.z = cvt_pk_bf16(h[4], h[5]); w.w = cvt_pk_bf16(h[6], h[7]);
                *(u32x4*)rowp = w; }
    }
};

template <class Epi, bool ALIGN_EPI = true, bool GATHER = false>
__device__ __forceinline__ void gemm_phase(PG8_LAS unsigned char* lds, const Gemm g, const Order& S, const Epi& E) {
    const int tid = threadIdx.x, wid = __builtin_amdgcn_readfirstlane(tid >> 6), lane = tid & 63, wr = wid >> 2, wc = wid & 3, fr = lane & 15, fq = lane >> 4;
    const int K = g.K, nt = K / BK;
    unsigned voffA[2], voffB[2]; int Rr[2], Cc[2];
#pragma unroll
    for (int i = 0; i < 2; ++i) { int R, C; stage_rc(tid * 16 + i * 8192, R, C); const int Rb = Epi::PERM ? ((R & ~31) + perm32(R & 31)) : R; Rr[i] = R; Cc[i] = C;
        voffA[i] = (unsigned)(R * K + C) * 2u; voffB[i] = (unsigned)(Rb * K + C) * 2u; }
    unsigned offC[2][2], offN[2][2];
#define PG8_LOAD_OFF(dst, U) do { _Pragma("unroll") for (int _h = 0; _h < 2; ++_h) _Pragma("unroll") for (int _i = 0; _i < 2; ++_i) \
        dst[_h][_i] = (unsigned)g.rowmap[(size_t)(U).pm * BM + _h * HALF + Rr[_i]] * (unsigned)(K * 2) + (unsigned)Cc[_i] * 2u; } while (0)
#define PG8_STAGE_A(bufoff, kptr, H, NXT) do { _Pragma("unroll") for (int _i = 0; _i < 2; ++_i) { \
        const char* _p = GATHER ? ((const char*)(kptr) + ((NXT) ? offN[H][_i] : offC[H][_i])) : ((const char*)(kptr) + (size_t)(H) * hstep + voffA[_i]); \
        __builtin_amdgcn_global_load_lds((const unsigned*)_p, (PG8_LAS unsigned*)(lds + (bufoff) + ldsw + _i * 8192), 16, 0, 0); } } while (0)
    const size_t kstep = (size_t)(BK * 2);
    const size_t hstep = (size_t)HALF * K * 2;
    const size_t tstep = 2 * hstep;
    const unsigned ldsw = (unsigned)wid * 1024u;
    const int aoff = lds_byte(wr * 64 + fr, fq * 8), boff = lds_byte(wc * 32 + fr, fq * 8);
#define PG8_SA(b, h) (((b) * 2 + (h)) * HTB)
#define PG8_SB(b, h) ((4 + (b) * 2 + (h)) * HTB)
#define PG8_STAGE(bufoff, gbase, voff) do { _Pragma("unroll") for (int _i = 0; _i < 2; ++_i) \
        __builtin_amdgcn_global_load_lds((const unsigned*)((const char*)(gbase) + (voff)[_i]), (PG8_LAS unsigned*)(lds + (bufoff) + ldsw + _i * 8192), 16, 0, 0); } while (0)
#define PG8_LDA(dst, b, h) do { _Pragma("unroll") for (int m = 0; m < 4; ++m) _Pragma("unroll") for (int k = 0; k < 2; ++k) dst[m][k] = *(const PG8_LAS bf16x8*)(lds + PG8_SA(b, h) + aoff + m * 2048 + k * 1024); } while (0)
#define PG8_LDB(dst, b, h) do { _Pragma("unroll") for (int n = 0; n < 2; ++n) _Pragma("unroll") for (int k = 0; k < 2; ++k) dst[n][k] = *(const PG8_LAS bf16x8*)(lds + PG8_SB(b, h) + boff + n * 2048 + k * 1024); } while (0)
#define PG8_MMA(ai, bj, At, Bt) do { __builtin_amdgcn_s_setprio(1); _Pragma("unroll") for (int m = 0; m < 4; ++m) _Pragma("unroll") for (int n = 0; n < 2; ++n) _Pragma("unroll") for (int k = 0; k < 2; ++k) \
        acc[ai][bj][m][n] = __builtin_amdgcn_mfma_f32_16x16x32_bf16(Bt[n][k], At[m][k], acc[ai][bj][m][n], 0, 0, 0); __builtin_amdgcn_s_setprio(0); } while (0)
#define PG8_WAIT_V(n) asm volatile("s_waitcnt vmcnt(" #n ")" ::: "memory")
#define PG8_WAIT_L(n) asm volatile("s_waitcnt lgkmcnt(" #n ")" ::: "memory")
#define PG8_BAR __builtin_amdgcn_s_barrier()
#define PG8_SCHED __builtin_amdgcn_sched_barrier(0)
    Unit cur, nxt; int ui = 0;
    if (!S.next(0, cur)) return;
    f32x4 acc[2][2][4][2];
#pragma unroll
    for (int a = 0; a < 2; ++a)
#pragma unroll
        for (int b = 0; b < 2; ++b)
#pragma unroll
            for (int m = 0; m < 4; ++m)
#pragma unroll
                for (int n = 0; n < 2; ++n) acc[a][b][m][n] = (f32x4){0.f, 0.f, 0.f, 0.f};
    bf16x8 At[4][2], B0[2][2], B1[2][2];
    const char* cA = GATHER ? (const char*)g.A : (const char*)g.A + (size_t)cur.pm * tstep; const char* cB = (const char*)g.Bt + (size_t)cur.e * S.bstride + (size_t)cur.pn * tstep;
    if constexpr (GATHER) { PG8_LOAD_OFF(offC, cur); }
    PG8_STAGE(PG8_SB(0, 0), cB, voffB); PG8_STAGE(PG8_SB(0, 1), cB + hstep, voffB); PG8_STAGE_A(PG8_SA(0, 0), cA, 0, false); PG8_STAGE_A(PG8_SA(0, 1), cA, 1, false);
    if (wr == 1) PG8_BAR;
    PG8_WAIT_V(2); PG8_BAR;
    PG8_STAGE(PG8_SB(1, 0), cB + kstep, voffB); PG8_STAGE_A(PG8_SA(1, 0), cA + kstep, 0, false); PG8_STAGE(PG8_SB(1, 1), cB + hstep + kstep, voffB);
    PG8_WAIT_V(6); PG8_BAR;
    for (;;) {
        const bool has_next = S.next(ui + 1, nxt);
        if constexpr (GATHER) { if (has_next) { PG8_LOAD_OFF(offN, nxt); } else {
#pragma unroll
            for (int _h = 0; _h < 2; ++_h) { offN[_h][0] = offC[_h][0]; offN[_h][1] = offC[_h][1]; } } }
        const char* nA = GATHER ? (const char*)g.A : (has_next ? (const char*)g.A + (size_t)nxt.pm * tstep : cA); const char* nB = has_next ? (const char*)g.Bt + (size_t)nxt.e * S.bstride + (size_t)nxt.pn * tstep : cB;
        for (int t = 0; t < nt; t += 2) {
            const bool last = (t == nt - 2);
            const char* a1 = cA + (size_t)(t + 1) * kstep;
            const char* a2 = last ? nA : cA + (size_t)(t + 2) * kstep; const char* b2 = last ? nB : cB + (size_t)(t + 2) * kstep;
            const char* a3 = a2 + kstep; const char* b3 = b2 + kstep;
            PG8_LDB(B0, 0, 0); PG8_LDB(B1, 0, 1); PG8_SCHED; PG8_LDA(At, 0, 0); PG8_STAGE_A(PG8_SA(1, 1), a1, 1, false);
            PG8_WAIT_V(8); PG8_WAIT_L(0); PG8_BAR; PG8_MMA(0, 0, At, B0); PG8_MMA(0, 1, At, B1); PG8_BAR; PG8_SCHED;
            PG8_LDA(At, 0, 1); PG8_STAGE(PG8_SB(0, 0), b2, voffB); PG8_STAGE(PG8_SB(0, 1), b2 + hstep, voffB); PG8_STAGE_A(PG8_SA(0, 0), a2, 0, last);
            PG8_WAIT_V(8); PG8_WAIT_L(0); PG8_BAR; PG8_MMA(1, 0, At, B0); PG8_MMA(1, 1, At, B1); PG8_BAR; PG8_SCHED;
            PG8_LDB(B0, 1, 0); PG8_LDB(B1, 1, 1); PG8_SCHED; PG8_LDA(At, 1, 0); PG8_STAGE_A(PG8_SA(0, 1), a2, 1, last);
            PG8_WAIT_V(8); PG8_WAIT_L(0); PG8_BAR; PG8_MMA(0, 0, At, B0); PG8_MMA(0, 1, At, B1); PG8_BAR; PG8_SCHED;
            PG8_LDA(At, 1, 1); PG8_STAGE(PG8_SB(1, 0), b3, voffB); PG8_STAGE(PG8_SB(1, 1), b3 + hstep, voffB); PG8_STAGE_A(PG8_SA(1, 0), a3, 0, last);
            PG8_WAIT_V(8); PG8_WAIT_L(0); PG8_BAR; PG8_MMA(1, 0, At, B0); PG8_MMA(1, 1, At, B1); PG8_BAR; PG8_SCHED;
        }
        if constexpr (ALIGN_EPI) { if (wr == 0) PG8_BAR; }
        E(acc, cur, wr, wc, fr, fq);
        if (!has_next) break;
#pragma unroll
        for (int a = 0; a < 2; ++a)
#pragma unroll
            for (int b = 0; b < 2; ++b)
#pragma unroll
                for (int m = 0; m < 4; ++m)
#pragma unroll
                    for (int n = 0; n < 2; ++n) acc[a][b][m][n] = (f32x4){0.f, 0.f, 0.f, 0.f};
        cur = nxt; cA = nA; cB = nB; ++ui;
        if constexpr (GATHER) {
#pragma unroll
            for (int _h = 0; _h < 2; ++_h) { offC[_h][0] = offN[_h][0]; offC[_h][1] = offN[_h][1]; } }
        if constexpr (ALIGN_EPI) { if (wr == 1) PG8_BAR; }
    }
    PG8_WAIT_V(0);
    if constexpr (!ALIGN_EPI) { if (wr == 0) PG8_BAR; }
    PG8_BAR;
#undef PG8_SA
#undef PG8_SB
#undef PG8_STAGE
#undef PG8_STAGE_A
#undef PG8_LOAD_OFF
#undef PG8_LDA
#undef PG8_LDB
#undef PG8_MMA
#undef PG8_WAIT_V
#undef PG8_WAIT_L
#undef PG8_BAR
#undef PG8_SCHED
}
}

struct Args { const float* in[24]; float* out; unsigned char* ws; int ph_lo, ph_hi; };
enum { I_X = 0, I_C, I_CTX, I_CCTX, I_WADA, I_BADA, I_N1G, I_N2G, I_WIN, I_QNG, I_KNG, I_SINK, I_CONVW, I_CONVB, I_LWR, I_LBR, I_LWI, I_LBI, I_LAM, I_WOUT, I_WROUTER, I_WGATE, I_WUP, I_WDOWN };

constexpr int N_ITEMS_ALL = 16 * 56 + 16 * 32 + 3 * NE * 16 * 32;
constexpr int N_ITEMS_P0 = 16 * 56 + 16 * 32;
constexpr int DEFER_PER_WAVE = 6, N_DEFER = 144 * NWAVES * DEFER_PER_WAVE;
struct TItem { const float* W; int N, k0, n0; bf16_t* dst; };
__device__ __forceinline__ TItem decode_item(const Args& a, unsigned char* ws, int it) {
    constexpr int I_IN = 16 * 56, I_OUT = 16 * 32, I_EXP = 16 * 32;
    bf16_t* WinT = (bf16_t*)(ws + WS_WIN); bf16_t* WoutT = (bf16_t*)(ws + WS_WOUT); bf16_t* WupT = (bf16_t*)(ws + WS_WUP); bf16_t* WdnT = (bf16_t*)(ws + WS_WDN);
    TItem t; int r = it;
    if (r < I_IN) { const int kb = r / 56, nb = r % 56; t.W = a.in[I_WIN]; t.N = NIN; t.k0 = 64 * kb; t.n0 = 32 * nb; t.dst = WinT + (size_t)(32 * nb) * DM; return t; } r -= I_IN;
    if (r < I_OUT) { const int kb = r / 32, nb = r % 32; t.W = a.in[I_WOUT]; t.N = DM; t.k0 = 64 * kb; t.n0 = 32 * nb; t.dst = WoutT + (size_t)(32 * nb) * DM; return t; } r -= I_OUT;
    const int which = r / (NE * I_EXP); r -= which * NE * I_EXP;
    const int e = r / I_EXP; r -= e * I_EXP; const int kb = r / 32, nb = r % 32, n0 = 32 * nb;
    t.N = DM; t.k0 = 64 * kb; t.n0 = n0;
    if (which == 0)      { t.W = a.in[I_WGATE] + (size_t)e * DM * DM; t.dst = WupT + ((size_t)e * 2048 + 256 * (n0 >> 7) + (n0 & 127)) * DM; }
    else if (which == 1) { t.W = a.in[I_WUP] + (size_t)e * DM * DM;   t.dst = WupT + ((size_t)e * 2048 + 256 * (n0 >> 7) + 128 + (n0 & 127)) * DM; }
    else                 { t.W = a.in[I_WDOWN] + (size_t)e * DM * DM; t.dst = WdnT + ((size_t)e * 1024 + n0) * DM; }
    return t;
}
__device__ __forceinline__ void transpose_store(const TItem& t, LAS float* scr, int lane) {
    const int c = lane & 7;
#pragma unroll
    for (int j = 0; j < 4; ++j) { const int n = (lane >> 3) + 8 * j; const LAS float* s = scr + (8 * c) * 33 + n;
        u32x4 o; o.x = pk2(s[0 * 33], s[1 * 33]); o.y = pk2(s[2 * 33], s[3 * 33]); o.z = pk2(s[4 * 33], s[5 * 33]); o.w = pk2(s[6 * 33], s[7 * 33]);
        *(u32x4*)(t.dst + (size_t)n * DM + t.k0 + 8 * c) = o; }
}
__device__ __forceinline__ void transpose_pair(const TItem& t0, const TItem& t1, bool two, LAS float* scr, int lane) {
    float tv0[32], tv1[32];
#pragma unroll
    for (int i = 0; i < 32; ++i) { const int kk = 2 * i + (lane >> 5); tv0[i] = t0.W[(size_t)(t0.k0 + kk) * t0.N + t0.n0 + (lane & 31)]; }
    if (two) {
#pragma unroll
        for (int i = 0; i < 32; ++i) { const int kk = 2 * i + (lane >> 5); tv1[i] = t1.W[(size_t)(t1.k0 + kk) * t1.N + t1.n0 + (lane & 31)]; }
    }
#pragma unroll
    for (int i = 0; i < 32; ++i) { const int kk = 2 * i + (lane >> 5); scr[kk * 33 + (lane & 31)] = tv0[i]; }
    if (two) {
#pragma unroll
        for (int i = 0; i < 32; ++i) { const int kk = 2 * i + (lane >> 5); scr[2112 + kk * 33 + (lane & 31)] = tv1[i]; }
    }
    asm volatile("s_waitcnt lgkmcnt(0)" ::: "memory");
    transpose_store(t0, scr, lane);
    if (two) transpose_store(t1, scr + 2112, lane);
    asm volatile("s_waitcnt lgkmcnt(0)" ::: "memory");
}

__device__ __forceinline__ void phase0(const Args& a, LAS unsigned char* lds) {
    const int tid = threadIdx.x, lane = tid & 63, wid = tid >> 6;
    unsigned char* ws = a.ws;
    if (blockIdx.x < 48) {
        const int item = blockIdx.x;
        LAS float* sc = (LAS float*)lds;
        LAS float* accL = (LAS float*)(lds + 17 * 1024 * 4);
        for (int i = tid; i < 17 * 1024; i += NTHREADS) { const int r = i >> 10, k = i & 1023; const float v = (r < 16) ? a.in[I_C][r * 1024 + k] : a.in[I_CCTX][k]; sc[i] = v / (1.0f + __expf(-v)); }
        for (int i = tid; i < 17 * 128; i += NTHREADS) accL[i] = 0.f;
        __syncthreads();
        const int kg = tid >> 5, cl = tid & 31;
        f32x4 acc[17];
#pragma unroll
        for (int r = 0; r < 17; ++r) acc[r] = (f32x4){0.f, 0.f, 0.f, 0.f};
        const float* wp = a.in[I_WADA] + (size_t)(kg * 64) * 6144 + item * 128 + 4 * cl;
        for (int k8 = 0; k8 < 64; k8 += 8) {
            f32x4 w[8];
#pragma unroll
            for (int u = 0; u < 8; ++u) w[u] = *(const f32x4*)(wp + (size_t)(k8 + u) * 6144);
#pragma unroll
            for (int u = 0; u < 8; ++u)
#pragma unroll
                for (int r = 0; r < 17; ++r) acc[r] += w[u] * sc[r * 1024 + kg * 64 + k8 + u];
        }
        for (int round = 0; round < 16; ++round) {
            if (kg == round) {
#pragma unroll
                for (int r = 0; r < 17; ++r) { LAS f32x4* p = (LAS f32x4*)(accL + r * 128 + 4 * cl); *p = *p + acc[r]; }
            }
            __syncthreads();
        }
        float* mod = (float*)(ws + WS_MOD);
        for (int i = tid; i < 17 * 128; i += NTHREADS) { const int r = i >> 7, cc = i & 127; mod[r * 6144 + item * 128 + cc] = accL[i] + a.in[I_BADA][item * 128 + cc]; }
        __syncthreads();
    }
    for (int f = blockIdx.x * NTHREADS + tid; f < 16384; f += gridDim.x * NTHREADS) {
        const int ln = f & 63, s = (f >> 6) & 3, ct = (f >> 8) & 1, mat = (f >> 9) & 1, dn = f >> 10;
        const float* w = a.in[mat ? I_LWI : I_LWR] + (size_t)dn * 4096 + ct * 32 + (ln & 31);
        float t8[8];
#pragma unroll
        for (int jj = 0; jj < 8; ++jj) t8[jj] = w[(16 * s + 8 * (ln >> 5) + jj) * 64];
        *(bf16x8*)(ws + WS_LW + (size_t)f * 16) = pack8(t8);
    }
    LAS float* scr = (LAS float*)(lds + wid * 16896);
    const int gw = blockIdx.x * NWAVES + wid, NGW = gridDim.x * NWAVES;
    const int NITEMS = (gridDim.x == 256) ? N_ITEMS_P0 : N_ITEMS_ALL;
    for (int it = gw; it < NITEMS; it += 2 * NGW) {
        const bool two = (it + NGW) < NITEMS;
        const TItem t0 = decode_item(a, ws, it); const TItem t1 = decode_item(a, ws, two ? it + NGW : it);
        transpose_pair(t0, t1, two, scr, lane);
    }
}

__device__ __forceinline__ void deferred_weight_copies(const Args& a, LAS unsigned char* lds) {
    if (gridDim.x != 256 || blockIdx.x < 112) return;
    const int lane = threadIdx.x & 63, wid = threadIdx.x >> 6;
    LAS float* scr = (LAS float*)(lds + wid * 16896);
    const int w = (blockIdx.x - 112) * NWAVES + wid;
    const int base = N_ITEMS_ALL - N_DEFER + w * DEFER_PER_WAVE;
#pragma unroll 1
    for (int i = 0; i < DEFER_PER_WAVE; i += 2) {
        const TItem t0 = decode_item(a, a.ws, base + i); const TItem t1 = decode_item(a, a.ws, base + i + 1);
        transpose_pair(t0, t1, true, scr, lane);
    }
}

__device__ __forceinline__ void load_row(const float* src, int lane, f32x4* v) {
#pragma unroll
    for (int j = 0; j < 4; ++j) v[j] = *((const f32x4*)src + lane + 64 * j);
}
__device__ __forceinline__ void norm_mod_vals(const f32x4* v, const float* gn, const float* shift, const float* scale, bf16_t* dst, int lane, f32x4* keep) {
    float s = 0.f;
#pragma unroll
    for (int j = 0; j < 4; ++j) s += (v[j].x * v[j].x + v[j].y * v[j].y) + (v[j].z * v[j].z + v[j].w * v[j].w);
    const float rstd = rsqrtf(wave_sum(s) * (1.0f / DM) + EPSN);
#pragma unroll
    for (int j = 0; j < 4; ++j) {
        const f32x4 g = *((const f32x4*)gn + lane + 64 * j), sh = *((const f32x4*)shift + lane + 64 * j), sc = *((const f32x4*)scale + lane + 64 * j);
        const f32x4 o = (v[j] * rstd * g) * (sc + 1.0f) + sh;
        if (keep) keep[j] = o;
        u32x2 w; w.x = pk2(o.x, o.y); w.y = pk2(o.z, o.w);
        *((u32x2*)dst + lane + 64 * j) = w;
    }
}
__device__ __forceinline__ const float* p1_src(const Args& a, int m) { return (m < ML) ? a.in[I_X] + (size_t)m * DM : a.in[I_CTX] + (size_t)(m - ML) * DM; }
__device__ __forceinline__ void phase1(const Args& a) {
    const int lane = threadIdx.x & 63, wid = threadIdx.x >> 6;
    const int gw = blockIdx.x * NWAVES + wid, NGW = gridDim.x * NWAVES;
    const float* mod = (const float*)(a.ws + WS_MOD); bf16_t* H = (bf16_t*)(a.ws + WS_H);
    for (int m0 = gw; m0 < MT; m0 += 4 * NGW) {
        f32x4 v[4][4];
#pragma unroll
        for (int r = 0; r < 4; ++r) { const int m = m0 + r * NGW; if (m < MT) load_row(p1_src(a, m), lane, v[r]); }
#pragma unroll
        for (int r = 0; r < 4; ++r) { const int m = m0 + r * NGW;
            if (m < MT) { const int mr = (m < ML) ? (m >> 12) : 16; norm_mod_vals(v[r], a.in[I_N1G], mod + mr * 6144, mod + mr * 6144 + 1024, H + (size_t)m * DM, lane, nullptr); } }
    }
}

__device__ __forceinline__ void attn_unit(const Args& a, LAS unsigned char* lds, int unit) {
    int tid_ = threadIdx.x; asm volatile("" : "+v"(tid_));
    const int tid = tid_, lane = tid & 63, wid = __builtin_amdgcn_readfirstlane(tid >> 6), r32 = lane & 31, hi = lane >> 5;
    const int b = unit >> 6, hk = (unit >> 5) & 1, qb = unit & 31;
    const int g = wid >> 1, hq = hk * 4 + g, qhalf = wid & 1;
    const bf16_t* QKV = (const bf16_t*)(a.ws + WS_QKV);
    bf16_t* AO = (bf16_t*)(a.ws + WS_AO);
    LAS unsigned char* Kl = lds;
    LAS unsigned char* Vl = lds + 16384;
    const float FR = 0.8304820237218406f;
    bf16x8 qf[2][4];
#pragma unroll
    for (int qt = 0; qt < 2; ++qt) {
        const int t = qb * 128 + qhalf * 64 + qt * 32 + r32;
        const bf16_t* qp = QKV + (size_t)(b * SEQL + t) * NIN + hq * 64 + 8 * hi;
        float x[4][8]; float ss = 0.f;
#pragma unroll
        for (int s = 0; s < 4; ++s) { unpack8(*(const u32x4*)(qp + 16 * s), x[s]);
#pragma unroll
            for (int j = 0; j < 8; ++j) ss += x[s][j] * x[s][j]; }
        ss += __shfl_xor(ss, 32);
        const float rstd = rsqrtf(ss * (1.0f / 64.0f) + EPSN);
#pragma unroll
        for (int s = 0; s < 4; ++s)
#pragma unroll
            for (int j = 0; j < 8; ++j) x[s][j] *= rstd * a.in[I_QNG][16 * s + 8 * hi + j];
        const float prow = (float)(t >> 6), pcol = (float)(t & 63);
        const float C2 = 0.125f * LOG2E;
#pragma unroll
        for (int j = 0; j < 8; ++j) {
            const float invf = exp2f(-(float)(8 * hi + j) * FR);
            float sn, cs;
            sn = __sinf(prow * invf); cs = __cosf(prow * invf);
            { const float x1 = x[0][j], x2 = x[1][j]; x[0][j] = (x1 * cs - x2 * sn) * C2; x[1][j] = (x2 * cs + x1 * sn) * C2; }
            sn = __sinf(pcol * invf); cs = __cosf(pcol * invf);
            { const float x1 = x[2][j], x2 = x[3][j]; x[2][j] = (x1 * cs - x2 * sn) * C2; x[3][j] = (x2 * cs + x1 * sn) * C2; }
        }
#pragma unroll
        for (int s = 0; s < 4; ++s) qf[qt][s] = pack8(x[s]);
    }
    float mrun[2], lsum[2]; f32x16 O[2][2];
    float sinit; bool fixedref;
    { const float sk = a.in[I_SINK][hq] * LOG2E;
      float gq = fabsf(a.in[I_QNG][lane]), gk = fabsf(a.in[I_KNG][lane]);
#pragma unroll
      for (int o = 1; o < 64; o <<= 1) { gq = fmaxf(gq, __shfl_xor(gq, o)); gk = fmaxf(gk, __shfl_xor(gk, o)); }
      const float mref = fmaxf(8.0f * gq * gk * LOG2E * 1.02f + 0.01f, sk);
      fixedref = mref < 64.0f; sinit = fixedref ? -mref : 0.f;
#pragma unroll
      for (int qt = 0; qt < 2; ++qt) { mrun[qt] = sk; lsum[qt] = hi ? 0.f : (fixedref ? __builtin_amdgcn_exp2f(sk - mref) : 1.f); O[qt][0] = f32x16{}; O[qt][1] = f32x16{}; } }

    const int skey = tid >> 2, sp = tid & 3, sa = sp >> 1, sfh = sp & 1;
#define CHUNK_VALID(cc) ((cc) < 2 || ((qb - 1 + ((cc) - 2)) >= 0 && (qb - 1 + ((cc) - 2)) <= 31))
#define CHUNK_ROW0(cc) ((cc) < 2 ? ((size_t)ML + b * LCTX + (cc) * 128) : ((size_t)b * SEQL + (qb - 1 + ((cc) - 2)) * 128))
#define LOAD_KV(cc) do { const size_t kr_ = CHUNK_ROW0(cc) + skey; const bf16_t* kp_ = QKV + kr_ * NIN + 512 + hk * 64 + sa * 32 + 8 * sfh; pk1 = *(const u32x4*)kp_; pk2_ = *(const u32x4*)(kp_ + 16); \
        const bf16_t* vp_ = QKV + kr_ * NIN + 640 + hk * 64 + 16 * sp; pv0 = *(const u32x4*)vp_; pv1 = *(const u32x4*)(vp_ + 8); } while (0)
    u32x4 pk1, pk2_, pv0, pv1;
    LOAD_KV(0);
    for (int c = 0; c < 5; ++c) {
        if (!CHUNK_VALID(c)) continue;
        const int kb = (c < 2) ? 0 : qb - 1 + (c - 2);
        __syncthreads();
        {
            int sfh_ = sfh, sa_ = sa; asm volatile("" : "+v"(sfh_), "+v"(sa_));
            float x1[8], x2[8]; unpack8(pk1, x1); unpack8(pk2_, x2);
            const u32x4 v0 = pv0, v1 = pv1;
            { int cn = c + 1; if (cn < 5 && !CHUNK_VALID(cn)) ++cn; if (cn < 5 && CHUNK_VALID(cn)) LOAD_KV(cn); }
            float ss = 0.f;
#pragma unroll
            for (int j = 0; j < 8; ++j) ss += x1[j] * x1[j] + x2[j] * x2[j];
            ss += __shfl_xor(ss, 1); ss += __shfl_xor(ss, 2);
            const float rstd = rsqrtf(ss * (1.0f / 64.0f) + EPSN);
            const int tk = kb * 128 + skey; const float pos = sa ? (float)(tk & 63) : (float)(tk >> 6);
#pragma unroll
            for (int j = 0; j < 8; ++j) {
                float v1_ = x1[j] * rstd * a.in[I_KNG][sa_ * 32 + 8 * sfh_ + j], v2_ = x2[j] * rstd * a.in[I_KNG][sa_ * 32 + 16 + 8 * sfh_ + j];
                if (c >= 2) { const float ang = pos * __builtin_amdgcn_exp2f(-(float)(8 * sfh_ + j) * FR); const float sn = __sinf(ang), cs = __cosf(ang); const float o1 = v1_ * cs - v2_ * sn, o2 = v2_ * cs + v1_ * sn; v1_ = o1; v2_ = o2; }
                x1[j] = v1_; x2[j] = v2_;
            }
            *(LAS bf16x8*)(Kl + (4 * sa + sfh) * 2048 + skey * 16) = pack8(x1);
            *(LAS bf16x8*)(Kl + (4 * sa + 2 + sfh) * 2048 + skey * 16) = pack8(x2);
            *(LAS u32x4*)(Vl + (sp >> 1) * 8192 + skey * 64 + (sp & 1) * 32) = v0;
            *(LAS u32x4*)(Vl + (sp >> 1) * 8192 + skey * 64 + (sp & 1) * 32 + 16) = v1;
        }
        __syncthreads();
        for (int kt = 0; kt < 4; ++kt) {
            if (c == 2 && kt < qhalf * 2) continue;
            if (c == 4 && kt > qhalf * 2 + 1) continue;
            bf16x8 kf[4];
#pragma unroll
            for (int s = 0; s < 4; ++s) kf[s] = *(const LAS bf16x8*)(Kl + (2 * s + hi) * 2048 + (kt * 32 + r32) * 16);
            bf16x8 pf[2][2];
#pragma unroll
            for (int qt = 0; qt < 2; ++qt) {
                f32x16 S;
#pragma unroll
                for (int r = 0; r < 16; ++r) S[r] = sinit;
#pragma unroll
                for (int s = 0; s < 4; ++s) S = __builtin_amdgcn_mfma_f32_32x32x16_bf16(kf[s], qf[qt][s], S, 0, 0, 0);
                const int qq = qhalf * 64 + qt * 32 + r32;
                if (c == 2) {
#pragma unroll
                    for (int r = 0; r < 16; ++r) { const int kk = kt * 32 + crow(r, hi); if (kk < qq) S[r] = -1e30f; }
                } else if (c == 4) {
#pragma unroll
                    for (int r = 0; r < 16; ++r) { const int kk = kt * 32 + crow(r, hi); if (kk > qq) S[r] = -1e30f; }
                }
                if (fixedref) {
                    float ps = 0.f;
#pragma unroll
                    for (int r = 0; r < 16; ++r) { S[r] = __builtin_amdgcn_exp2f(S[r]); ps += S[r]; }
                    lsum[qt] += ps;
                } else {
                    float mx = S[0];
#pragma unroll
                    for (int r = 1; r < 16; ++r) mx = fmaxf(mx, S[r]);
                    mx = fmaxf(mx, __shfl_xor(mx, 32));
                    const float mnew = fmaxf(mrun[qt], mx), alpha = __builtin_amdgcn_exp2f(mrun[qt] - mnew);
                    mrun[qt] = mnew;
                    float ps = 0.f;
#pragma unroll
                    for (int r = 0; r < 16; ++r) { S[r] = __builtin_amdgcn_exp2f(S[r] - mnew); ps += S[r]; }
                    lsum[qt] = lsum[qt] * alpha + ps;
#pragma unroll
                    for (int r = 0; r < 16; ++r) { O[qt][0][r] *= alpha; O[qt][1][r] *= alpha; }
                }
#pragma unroll
                for (int s2 = 0; s2 < 2; ++s2) { u32x4 w; w.x = pg8::cvt_pk_bf16(S[8 * s2 + 0], S[8 * s2 + 1]); w.y = pg8::cvt_pk_bf16(S[8 * s2 + 2], S[8 * s2 + 3]); w.z = pg8::cvt_pk_bf16(S[8 * s2 + 4], S[8 * s2 + 5]); w.w = pg8::cvt_pk_bf16(S[8 * s2 + 6], S[8 * s2 + 7]); pf[qt][s2] = __builtin_bit_cast(bf16x8, w); }
            }
            const int gi = lane >> 4, li = lane & 15;
#pragma unroll
            for (int dt = 0; dt < 2; ++dt)
#pragma unroll
                for (int s2 = 0; s2 < 2; ++s2) {
                    const LAS unsigned char* vpz = Vl + dt * 8192 + (kt * 32 + 16 * s2 + 4 * hi + (li >> 2)) * 64 + (16 * (gi & 1) + 4 * (li & 3)) * 2;
                    const s16x4 lo = __builtin_bit_cast(s16x4, __builtin_amdgcn_ds_read_tr16_b64_v4i16((LAS s16x4*)vpz));
                    const s16x4 hh = __builtin_bit_cast(s16x4, __builtin_amdgcn_ds_read_tr16_b64_v4i16((LAS s16x4*)(vpz + 512)));
                    const bf16x8 vf = (bf16x8){lo[0], lo[1], lo[2], lo[3], hh[0], hh[1], hh[2], hh[3]};
#pragma unroll
                    for (int qt = 0; qt < 2; ++qt) O[qt][dt] = __builtin_amdgcn_mfma_f32_32x32x16_bf16(vf, pf[qt][s2], O[qt][dt], 0, 0, 0);
                }
        }
    }
#pragma unroll
    for (int qt = 0; qt < 2; ++qt) {
        const float l = lsum[qt] + __shfl_xor(lsum[qt], 32), inv = 1.0f / l;
        const int t = qb * 128 + qhalf * 64 + qt * 32 + r32;
        bf16_t* op = AO + (size_t)(b * SEQL + t) * DM + hq * 64;
#pragma unroll
        for (int dt = 0; dt < 2; ++dt)
#pragma unroll
            for (int rr = 0; rr < 4; ++rr) { u32x2 w; w.x = pk2(O[qt][dt][4 * rr] * inv, O[qt][dt][4 * rr + 1] * inv); w.y = pk2(O[qt][dt][4 * rr + 2] * inv, O[qt][dt][4 * rr + 3] * inv);
                *(u32x2*)(op + 32 * dt + 8 * rr + 4 * hi) = w; }
    }
}

__device__ __forceinline__ float gelu_tanh(float x) { const float u = 0.7978845608028654f * (x + 0.044715f * x * x * x); const float t = 1.0f - 2.0f / (1.0f + __expf(2.0f * u)); return 0.5f * x * (1.0f + t); }
__device__ __forceinline__ float fast_sigmoid(float x) { return __builtin_amdgcn_rcpf(1.0f + __builtin_amdgcn_exp2f(-x * LOG2E)); }
__device__ __forceinline__ float gelu_fast(float x) { const float u = 0.7978845608028654f * (x + 0.044715f * x * x * x); const float t = 1.0f - 2.0f * __builtin_amdgcn_rcpf(1.0f + __builtin_amdgcn_exp2f(2.0f * LOG2E * u)); return 0.5f * x * (1.0f + t); }
template <int MODE>
__device__ __forceinline__ void lru_phase(const Args& a, LAS unsigned char* lds) {
    const int tid = threadIdx.x, lane = tid & 63, wid = __builtin_amdgcn_readfirstlane(tid >> 6), r32 = lane & 31, hi = lane >> 5;
    const bf16_t* QKV = (const bf16_t*)(a.ws + WS_QKV);
    bf16_t* AO = (bf16_t*)(a.ws + WS_AO);
    float* AGG = (float*)(a.ws + WS_AGG);
    const u32x4* LW = (const u32x4*)(a.ws + WS_LW);
    LAS float* xcf = (LAS float*)lds;
    LAS u32x4* wL = (LAS u32x4*)(lds + 34816);
    LAS bf16_t* grL = (LAS bf16_t*)(lds + 67584);
    LAS float* wtA = (LAS float*)(lds + 83968);
    LAS float* wtB = (LAS float*)(lds + 86016);
    LAS float* cwL = (LAS float*)(lds + 88064);
    LAS float* carL = (LAS float*)(lds + 89344);
    LAS float* stg = (LAS float*)(lds + 100352);
    const int tt = wid & 3, ct = wid >> 2;
    const int ctok = tid >> 2, ccg = tid & 3;
    const int jch = ct * 32 + r32;
    for (int v = blockIdx.x; v < 256; v += gridDim.x) {
        const int n = v & 7, b = v >> 4, half = (v >> 3) & 1;
        const int ch0 = n * 64 + 16 * ccg;
        __syncthreads();
        if (tid < 320) { const int r = tid >> 6, c = tid & 63; cwL[tid] = (r < 4) ? a.in[I_CONVW][r * 512 + n * 64 + c] : a.in[I_CONVB][n * 64 + c]; }
        for (int i = tid; i < 2048; i += NTHREADS) wL[i] = LW[(size_t)(((i >> 10) * 8 + n) * 1024) + (i & 1023)];
        float nbr[2], nbi[2], c8[2];
#pragma unroll
        for (int dir = 0; dir < 2; ++dir) {
            const int chj = n * 64 + jch;
            nbr[dir] = -a.in[I_LBR][dir * 512 + chj] * LOG2E; nbi[dir] = -a.in[I_LBI][dir * 512 + chj] * LOG2E;
            const float lam = a.in[I_LAM][dir * 512 + chj];
            c8[dir] = -8.0f * ((lam > 15.f) ? __expf(-lam) : log1pf(__expf(-lam)));
        }
        if (MODE == 1) {
            const float* ag = AGG + ((size_t)((b * 8 + n) * 2) * 34) * 128;
            for (int i = tid; i < 2 * 34 * 32; i += NTHREADS) *(LAS f32x4*)(stg + 4 * i) = *(const f32x4*)(ag + 4 * i);
            __syncthreads();
            if (tid < 128) { const int dir = wid, c = lane; const LAS float* al = stg + dir * 34 * 128 + c;
                float h = 0.f;
                for (int s2 = 0; s2 < 34; ++s2) { const int T = dir ? 33 - s2 : s2 - 2; const int k = T - 16 * half;
                    if (s2 >= 2 && k >= 0 && k < 16) carL[(dir * 17 + k) * 64 + c] = h;
                    if (dir == (half ? 0 : 1) && s2 >= 2 && k >= 0 && k < 16) break;
                    h = al[s2 * 128] * h + al[s2 * 128 + 64]; } }
        }
        __syncthreads();
        const int NT = (MODE == 0) ? 17 : 16;
        u32x4 xin[4][2], gin[2];
#define LOAD_INPUTS(TL) do { const int tl_ = (TL); const bool isctx_ = tl_ < 2; const int tile_ = isctx_ ? tl_ : tl_ - 2; const int LS_ = isctx_ ? LCTX : SEQL; \
            const size_t rowbase_ = isctx_ ? ((size_t)ML + b * LCTX) : ((size_t)b * SEQL); const int tok_ = tile_ * 128 + ctok; \
            _Pragma("unroll") for (int j = 0; j < 4; ++j) { const int tj = tok_ + j - 2; \
                if (tj >= 0 && tj < LS_) { const bf16_t* xp = QKV + (rowbase_ + tj) * NIN + 768 + ch0; xin[j][0] = *(const u32x4*)xp; xin[j][1] = *(const u32x4*)(xp + 8); } \
                else { xin[j][0] = (u32x4){0u, 0u, 0u, 0u}; xin[j][1] = (u32x4){0u, 0u, 0u, 0u}; } } \
            if (MODE == 1) { const bf16_t* gp = QKV + (rowbase_ + tok_) * NIN + 1280 + ch0; gin[0] = *(const u32x4*)gp; gin[1] = *(const u32x4*)(gp + 8); } } while (0)
        const int tl0 = (MODE == 0) ? 17 * half : 2 + 16 * half;
        const bool desc = (MODE == 1) && (half == 0);
        LOAD_INPUTS(desc ? tl0 + NT - 1 : tl0);
        for (int i = 0; i < NT; ++i) {
            const int k = desc ? NT - 1 - i : i;
            const int tl = tl0 + k;
            const bool isctx = tl < 2; const int tile = isctx ? tl : tl - 2;
            const size_t rowbase = isctx ? ((size_t)ML + b * LCTX) : ((size_t)b * SEQL);
            const int t0 = tile * 128;
            {
                float acc[16];
#pragma unroll
                for (int q = 0; q < 4; ++q) { const f32x4 bv = *(const LAS f32x4*)(cwL + 4 * 64 + 16 * ccg + 4 * q); acc[4 * q] = bv.x; acc[4 * q + 1] = bv.y; acc[4 * q + 2] = bv.z; acc[4 * q + 3] = bv.w; }
#pragma unroll
                for (int j = 0; j < 4; ++j) { float xv[16]; unpack8(xin[j][0], xv); unpack8(xin[j][1], xv + 8);
#pragma unroll
                    for (int q = 0; q < 4; ++q) { const f32x4 wv = *(const LAS f32x4*)(cwL + j * 64 + 16 * ccg + 4 * q);
                        acc[4 * q] += wv.x * xv[4 * q]; acc[4 * q + 1] += wv.y * xv[4 * q + 1]; acc[4 * q + 2] += wv.z * xv[4 * q + 2]; acc[4 * q + 3] += wv.w * xv[4 * q + 3]; } }
#pragma unroll
                for (int q = 0; q < 4; ++q) *(LAS f32x4*)(xcf + ctok * 68 + 16 * ccg + 4 * q) = (f32x4){acc[4 * q], acc[4 * q + 1], acc[4 * q + 2], acc[4 * q + 3]};
                if (MODE == 1) { *(LAS u32x4*)(grL + ctok * 64 + 16 * ccg) = gin[0]; *(LAS u32x4*)(grL + ctok * 64 + 16 * ccg + 8) = gin[1]; }
            }
            if (i + 1 < NT) LOAD_INPUTS(desc ? tl - 1 : tl + 1);
            __syncthreads();
            LAS float* hfL = stg;
#pragma unroll
            for (int dir = 0; dir < 2; ++dir) {
                if (MODE == 0 && dir == 0 && tl >= 18) continue;
                if (MODE == 0 && dir == 1 && tl >= 2 && tl <= 17) continue;
                float av[16], bv[16];
                {
                    f32x16 accR = f32x16{}, accI = f32x16{};
#pragma unroll
                    for (int s = 0; s < 4; ++s) { const LAS float* xp = xcf + (tt * 32 + r32) * 68 + 16 * s + 8 * hi; const f32x4 p0 = *(const LAS f32x4*)xp, p1 = *(const LAS f32x4*)(xp + 4);
                        float t8[8] = {p0.x, p0.y, p0.z, p0.w, p1.x, p1.y, p1.z, p1.w}; const bf16x8 af = pack8(t8);
                        const bf16x8 wrf = __builtin_bit_cast(bf16x8, wL[(((dir * 2 + 0) * 2 + ct) * 4 + s) * 64 + lane]), wif = __builtin_bit_cast(bf16x8, wL[(((dir * 2 + 1) * 2 + ct) * 4 + s) * 64 + lane]);
                        accR = __builtin_amdgcn_mfma_f32_32x32x16_bf16(af, wrf, accR, 0, 0, 0); accI = __builtin_amdgcn_mfma_f32_32x32x16_bf16(af, wif, accI, 0, 0, 0); }
                    const float cc8 = c8[dir], nr = nbr[dir], ni = nbi[dir];
#define LRU_GATE_LOOP(FALLBACK) _Pragma("unroll") for (int r = 0; r < 16; ++r) { const int tau = tt * 32 + crow(r, hi); \
                        const float rg = __builtin_amdgcn_rcpf(1.0f + __builtin_amdgcn_exp2f(__builtin_fmaf(accR[r], -LOG2E, nr))), ig = __builtin_amdgcn_rcpf(1.0f + __builtin_amdgcn_exp2f(__builtin_fmaf(accI[r], -LOG2E, ni))), xv = xcf[tau * 68 + jch]; \
                        const float log_a = cc8 * rg; av[r] = __builtin_amdgcn_exp2f(log_a * LOG2E); \
                        const float x2 = 2.0f * log_a; \
                        float om = -x2 * (1.0f + x2 * (0.5f + x2 * (0.16666667f + x2 * (0.041666668f + x2 * 0.008333334f)))); \
                        if (FALLBACK) { if (x2 <= -0.25f) om = 1.0f - __builtin_amdgcn_exp2f(x2 * LOG2E); } \
                        bv[r] = __builtin_amdgcn_sqrtf(om) * ig * xv; }
                    if (__builtin_expect(__any(-2.0f * cc8 >= 0.25f), 0)) { LRU_GATE_LOOP(true) } else { LRU_GATE_LOOP(false) }
#undef LRU_GATE_LOOP
                }
                float QA[8], QB[8];
                {
                    float qa[4], qb[4];
#pragma unroll
                    for (int g = 0; g < 4; ++g) { float A = 1.f, Bq = 0.f;
#pragma unroll
                        for (int ee = 0; ee < 4; ++ee) { const int r = 4 * g + (dir ? 3 - ee : ee); Bq = av[r] * Bq + bv[r]; A *= av[r]; }
                        qa[g] = A; qb[g] = Bq; }
#pragma unroll
                    for (int g = 0; g < 4; ++g) { const float pa = __shfl_xor(qa[g], 32), pb = __shfl_xor(qb[g], 32);
                        QA[2 * g] = hi ? pa : qa[g]; QA[2 * g + 1] = hi ? qa[g] : pa; QB[2 * g] = hi ? pb : qb[g]; QB[2 * g + 1] = hi ? qb[g] : pb; }
                }
                {
                    float AW = 1.f, BW = 0.f;
#pragma unroll
                    for (int qq = 0; qq < 8; ++qq) { const int q = dir ? 7 - qq : qq; BW = QA[q] * BW + QB[q]; AW *= QA[q]; }
                    if (hi == 0) { wtA[(dir * 4 + tt) * 64 + jch] = AW; wtB[(dir * 4 + tt) * 64 + jch] = BW; }
                }
                __syncthreads();
                if (MODE == 0) {
                    if (tt == 0 && hi == 0) { float A = 1.f, Bt = 0.f;
#pragma unroll
                        for (int ww = 0; ww < 4; ++ww) { const int w = dir ? 3 - ww : ww; const float sa = wtA[(dir * 4 + w) * 64 + jch], sb = wtB[(dir * 4 + w) * 64 + jch]; Bt = sa * Bt + sb; A *= sa; }
                        const int sig = isctx ? (dir ? 1 - tl : tl) : (dir ? 2 + 31 - tile : 2 + tile);
                        float* ag = AGG + ((size_t)((b * 8 + n) * 2 + dir) * 34 + sig) * 128 + jch; ag[0] = A; ag[64] = Bt; }
                } else {
                    float h = carL[(dir * 17 + k) * 64 + jch];
#pragma unroll
                    for (int ww = 0; ww < 4; ++ww) { const int w = dir ? 3 - ww : ww; const float sa = wtA[(dir * 4 + w) * 64 + jch], sb = wtB[(dir * 4 + w) * 64 + jch];
                        if (dir ? (w > tt) : (w < tt)) h = sa * h + sb; }
                    float hin[4] = {0.f, 0.f, 0.f, 0.f};
#pragma unroll
                    for (int qq = 0; qq < 8; ++qq) { const int q = dir ? 7 - qq : qq; hin[q >> 1] = ((q & 1) == hi) ? h : hin[q >> 1]; h = QA[q] * h + QB[q]; }
                    if (dir == (desc ? 1 : 0) && tt == (desc ? 0 : 3) && hi == 0 && i + 1 < NT) carL[(dir * 17 + (desc ? k - 1 : k + 1)) * 64 + jch] = h;
#pragma unroll
                    for (int g = 0; g < 4; ++g) { float hc = hin[g];
#pragma unroll
                        for (int ee = 0; ee < 4; ++ee) { const int r = 4 * g + (dir ? 3 - ee : ee); hc = av[r] * hc + bv[r];
                            const int tau = tt * 32 + crow(r, hi);
                            if (dir == 0) hfL[tau * 64 + jch] = hc;
                            else xcf[tau * 68 + jch] = (hfL[tau * 64 + jch] + hc) * gelu_fast(bf1(grL[tau * 64 + jch])); } }
                }
            }
            if (MODE == 1) {
                __syncthreads();
                float o[16];
#pragma unroll
                for (int q = 0; q < 4; ++q) { const f32x4 hv = *(const LAS f32x4*)(xcf + ctok * 68 + 16 * ccg + 4 * q); o[4 * q] = hv.x; o[4 * q + 1] = hv.y; o[4 * q + 2] = hv.z; o[4 * q + 3] = hv.w; }
                bf16_t* op = AO + (rowbase + t0 + ctok) * DM + 512 + ch0;
                *(bf16x8*)op = pack8(o); *(bf16x8*)(op + 8) = pack8(o + 8);
            }
        }
#undef LOAD_INPUTS
    }
}

constexpr size_t WS_HS = WS_HF;
constexpr size_t WS_XC = WS_IDX;
template <int PH>
__device__ __forceinline__ void lru_sweep(const Args& a, LAS unsigned char* lds) {
    const int tid = threadIdx.x, lane = tid & 63, wid = __builtin_amdgcn_readfirstlane(tid >> 6), r32 = lane & 31, hi = lane >> 5;
    const bf16_t* QKV = (const bf16_t*)(a.ws + WS_QKV);
    bf16_t* AO = (bf16_t*)(a.ws + WS_AO);
    float* HS = (float*)(a.ws + WS_HS);
    float* XC = (float*)(a.ws + WS_XC);
    const u32x4* LW = (const u32x4*)(a.ws + WS_LW);
    LAS float* xcf = (LAS float*)lds;
    LAS u32x4* wL = (LAS u32x4*)(lds + 34816);
    LAS bf16_t* grL = (LAS bf16_t*)(lds + 67584);
    LAS float* wtA = (LAS float*)(lds + 83968);
    LAS float* wtB = (LAS float*)(lds + 86016);
    LAS float* cwL = (LAS float*)(lds + 88064);
    LAS float* carry = (LAS float*)(lds + 89344);
    const int tt = wid & 3, ct = wid >> 2;
    const int ctok = tid >> 2, ccg = tid & 3;
    const int jch = ct * 32 + r32;
    for (int v = blockIdx.x; v < 256; v += gridDim.x) {
        const int n = v & 7, b = v >> 4, half = (v >> 3) & 1;
        const int dir = (PH == 0) ? half : 1 - half;
        const int ch0 = n * 64 + 16 * ccg;
        __syncthreads();
        if (tid < 320) { const int r = tid >> 6, c = tid & 63; cwL[tid] = (r < 4) ? a.in[I_CONVW][r * 512 + n * 64 + c] : a.in[I_CONVB][n * 64 + c]; }
        for (int i = tid; i < 1024; i += NTHREADS) wL[i] = LW[(size_t)((dir * 8 + n) * 1024) + i];
        if (tid < 64) carry[tid] = (PH == 0) ? 0.f : XC[((size_t)((b * 8 + n) * 2 + dir)) * 64 + tid];
        const int chj = n * 64 + jch;
        const float nr = -a.in[I_LBR][dir * 512 + chj] * LOG2E, ni = -a.in[I_LBI][dir * 512 + chj] * LOG2E;
        const float lam = a.in[I_LAM][dir * 512 + chj];
        const float cc8 = -8.0f * ((lam > 15.f) ? __expf(-lam) : log1pf(__expf(-lam)));
        __syncthreads();
        const int NT = (PH == 0) ? 18 : 16;
        u32x4 xin[4][2], gin[2];
#define SW_TILE(S_, ISCTX, TILE) const bool ISCTX = (PH == 0) && (S_) < 2; \
            const int TILE = (PH == 0) ? (ISCTX ? (dir ? 1 - (S_) : (S_)) : (dir ? 33 - (S_) : (S_) - 2)) : (dir ? 15 - (S_) : 16 + (S_))
#define SW_LOAD(S_) do { SW_TILE(S_, isctx_, tile_); const int LS_ = isctx_ ? LCTX : SEQL; \
            const size_t rowbase_ = isctx_ ? ((size_t)ML + b * LCTX) : ((size_t)b * SEQL); const int tok_ = tile_ * 128 + ctok; \
            _Pragma("unroll") for (int j = 0; j < 4; ++j) { const int tj = tok_ + j - 2; \
                if (tj >= 0 && tj < LS_) { const bf16_t* xp = QKV + (rowbase_ + tj) * NIN + 768 + ch0; xin[j][0] = *(const u32x4*)xp; xin[j][1] = *(const u32x4*)(xp + 8); } \
                else { xin[j][0] = (u32x4){0u, 0u, 0u, 0u}; xin[j][1] = (u32x4){0u, 0u, 0u, 0u}; } } \
            if (PH == 1) { const bf16_t* gp = QKV + (rowbase_ + tok_) * NIN + 1280 + ch0; gin[0] = *(const u32x4*)gp; gin[1] = *(const u32x4*)(gp + 8); } } while (0)
        SW_LOAD(0);
        for (int st = 0; st < NT; ++st) {
            SW_TILE(st, isctx, tile);
            const size_t rowbase = isctx ? ((size_t)ML + b * LCTX) : ((size_t)b * SEQL);
            const int t0 = tile * 128;
            {
                float acc[16];
#pragma unroll
                for (int q = 0; q < 4; ++q) { const f32x4 bv = *(const LAS f32x4*)(cwL + 4 * 64 + 16 * ccg + 4 * q); acc[4 * q] = bv.x; acc[4 * q + 1] = bv.y; acc[4 * q + 2] = bv.z; acc[4 * q + 3] = bv.w; }
#pragma unroll
                for (int j = 0; j < 4; ++j) { float xv[16]; unpack8(xin[j][0], xv); unpack8(xin[j][1], xv + 8);
#pragma unroll
                    for (int q = 0; q < 4; ++q) { const f32x4 wv = *(const LAS f32x4*)(cwL + j * 64 + 16 * ccg + 4 * q);
                        acc[4 * q] += wv.x * xv[4 * q]; acc[4 * q + 1] += wv.y * xv[4 * q + 1]; acc[4 * q + 2] += wv.z * xv[4 * q + 2]; acc[4 * q + 3] += wv.w * xv[4 * q + 3]; } }
#pragma unroll
                for (int q = 0; q < 4; ++q) *(LAS f32x4*)(xcf + ctok * 68 + 16 * ccg + 4 * q) = (f32x4){acc[4 * q], acc[4 * q + 1], acc[4 * q + 2], acc[4 * q + 3]};
                if (PH == 1) { *(LAS u32x4*)(grL + ctok * 64 + 16 * ccg) = gin[0]; *(LAS u32x4*)(grL + ctok * 64 + 16 * ccg + 8) = gin[1]; }
            }
            if (st + 1 < NT) SW_LOAD(st + 1);
            __syncthreads();
            float av[16], bv[16];
            {
                f32x16 accR = f32x16{}, accI = f32x16{};
#pragma unroll
                for (int s = 0; s < 4; ++s) { const LAS float* xp = xcf + (tt * 32 + r32) * 68 + 16 * s + 8 * hi; const f32x4 p0 = *(const LAS f32x4*)xp, p1 = *(const LAS f32x4*)(xp + 4);
                    float t8[8] = {p0.x, p0.y, p0.z, p0.w, p1.x, p1.y, p1.z, p1.w}; const bf16x8 af = pack8(t8);
                    const bf16x8 wrf = __builtin_bit_cast(bf16x8, wL[((0 * 2 + ct) * 4 + s) * 64 + lane]), wif = __builtin_bit_cast(bf16x8, wL[((1 * 2 + ct) * 4 + s) * 64 + lane]);
                    accR = __builtin_amdgcn_mfma_f32_32x32x16_bf16(af, wrf, accR, 0, 0, 0); accI = __builtin_amdgcn_mfma_f32_32x32x16_bf16(af, wif, accI, 0, 0, 0); }
#define LRU_GATE_LOOP(FALLBACK) _Pragma("unroll") for (int r = 0; r < 16; ++r) { const int tau = tt * 32 + crow(r, hi); \
                    const float rg = __builtin_amdgcn_rcpf(1.0f + __builtin_amdgcn_exp2f(__builtin_fmaf(accR[r], -LOG2E, nr))), ig = __builtin_amdgcn_rcpf(1.0f + __builtin_amdgcn_exp2f(__builtin_fmaf(accI[r], -LOG2E, ni))), xv = xcf[tau * 68 + jch]; \
                    const float log_a = cc8 * rg; av[r] = __builtin_amdgcn_exp2f(log_a * LOG2E); \
                    const float x2 = 2.0f * log_a; \
                    float om = -x2 * (1.0f + x2 * (0.5f + x2 * (0.16666667f + x2 * (0.041666668f + x2 * 0.008333334f)))); \
                    if (FALLBACK) { if (x2 <= -0.25f) om = 1.0f - __builtin_amdgcn_exp2f(x2 * LOG2E); } \
                    bv[r] = __builtin_amdgcn_sqrtf(om) * ig * xv; }
                if (__builtin_expect(__any(-2.0f * cc8 >= 0.25f), 0)) { LRU_GATE_LOOP(true) } else { LRU_GATE_LOOP(false) }
#undef LRU_GATE_LOOP
            }
            float hs[16];
            if (PH == 1) {
#pragma unroll
                for (int r = 0; r < 16; ++r) hs[r] = HS[(rowbase + t0 + tt * 32 + crow(r, hi)) * 512 + chj];
            }
#define SW_SCAN(DIR_) do { \
            float QA[8], QB[8]; \
            { \
                float qa[4], qb[4]; \
            _Pragma("unroll") \
                for (int g = 0; g < 4; ++g) { float A = 1.f, Bq = 0.f; \
            _Pragma("unroll") \
                    for (int ee = 0; ee < 4; ++ee) { const int r = 4 * g + (DIR_ ? 3 - ee : ee); Bq = av[r] * Bq + bv[r]; A *= av[r]; } \
                    qa[g] = A; qb[g] = Bq; } \
            _Pragma("unroll") \
                for (int g = 0; g < 4; ++g) { const float pa = __shfl_xor(qa[g], 32), pb = __shfl_xor(qb[g], 32); \
                    QA[2 * g] = hi ? pa : qa[g]; QA[2 * g + 1] = hi ? qa[g] : pa; QB[2 * g] = hi ? pb : qb[g]; QB[2 * g + 1] = hi ? qb[g] : pb; } \
            } \
            { \
                float AW = 1.f, BW = 0.f; \
            _Pragma("unroll") \
                for (int qq = 0; qq < 8; ++qq) { const int q = DIR_ ? 7 - qq : qq; BW = QA[q] * BW + QB[q]; AW *= QA[q]; } \
                if (hi == 0) { wtA[tt * 64 + jch] = AW; wtB[tt * 64 + jch] = BW; } \
            } \
            __syncthreads(); \
            { \
                float h = carry[(st & 1) * 64 + jch]; \
            _Pragma("unroll") \
                for (int ww = 0; ww < 4; ++ww) { const int w = DIR_ ? 3 - ww : ww; const float sa = wtA[w * 64 + jch], sb = wtB[w * 64 + jch]; \
                    if (DIR_ ? (w > tt) : (w < tt)) h = sa * h + sb; } \
                float hin[4] = {0.f, 0.f, 0.f, 0.f}; \
            _Pragma("unroll") \
                for (int qq = 0; qq < 8; ++qq) { const int q = DIR_ ? 7 - qq : qq; hin[q >> 1] = ((q & 1) == hi) ? h : hin[q >> 1]; h = QA[q] * h + QB[q]; } \
                if (tt == (DIR_ ? 0 : 3) && hi == 0) { \
                    carry[((st + 1) & 1) * 64 + jch] = h; \
                    if (PH == 0 && st == NT - 1) XC[((size_t)((b * 8 + n) * 2 + dir)) * 64 + jch] = h; \
                } \
                if (!isctx) { \
            _Pragma("unroll") \
                    for (int g = 0; g < 4; ++g) { float hc = hin[g]; \
            _Pragma("unroll") \
                        for (int ee = 0; ee < 4; ++ee) { const int r = 4 * g + (DIR_ ? 3 - ee : ee); hc = av[r] * hc + bv[r]; \
                            const int tau = tt * 32 + crow(r, hi); \
                            if (PH == 0) HS[(rowbase + t0 + tau) * 512 + chj] = hc; \
                            else xcf[tau * 68 + jch] = (hs[r] + hc) * gelu_fast(bf1(grL[tau * 64 + jch])); } } \
                } \
            } \
            } while (0)
            if (dir) SW_SCAN(1); else SW_SCAN(0);
#undef SW_SCAN
            if (PH == 1) {
                __syncthreads();
                float o[16];
#pragma unroll
                for (int q = 0; q < 4; ++q) { const f32x4 hv = *(const LAS f32x4*)(xcf + ctok * 68 + 16 * ccg + 4 * q); o[4 * q] = hv.x; o[4 * q + 1] = hv.y; o[4 * q + 2] = hv.z; o[4 * q + 3] = hv.w; }
                bf16_t* op = AO + (rowbase + t0 + ctok) * DM + 512 + ch0;
                *(bf16x8*)op = pack8(o); *(bf16x8*)(op + 8) = pack8(o + 8);
            }
        }
#undef SW_TILE
#undef SW_LOAD
    }
}

__device__ __forceinline__ void phase3a(const Args& a, LAS unsigned char* lds) {
    lru_sweep<0>(a, lds);
    unsigned* ctr = (unsigned*)(a.ws + WS_CTL) + 64;
    LAS int* slot = (LAS int*)(lds + 140000);
#pragma unroll 1
    for (int gg = 0; gg < 8; ++gg) {
        const int g = ((int)(blockIdx.x & 7) + gg) & 7;
        unsigned* qc = ctr + 256 + 64 * g;
        for (;;) {
            __syncthreads();
            if (threadIdx.x == 0) *slot = (int)atomicAdd(qc, 1u);
            __syncthreads();
            const int li = *slot;
            if (li >= 128) break;
#ifndef NO_ATTN
            attn_unit(a, lds, (g * 4 + (li >> 5)) * 32 + (li & 31));
#endif
        }
    }
    if (gridDim.x == 256) {
        constexpr int QN = (N_ITEMS_ALL - N_DEFER - N_ITEMS_P0) / 16;
        static_assert((N_ITEMS_ALL - N_DEFER - N_ITEMS_P0) % 16 == 0, "weight-copy queue granularity");
        const int lane = threadIdx.x & 63, wid = threadIdx.x >> 6;
        LAS float* scr = (LAS float*)(lds + wid * 16896);
        for (;;) {
            __syncthreads();
            if (threadIdx.x == 0) *slot = (int)atomicAdd(ctr + 128, 1u);
            __syncthreads();
            const int g = *slot;
            if (g >= QN) break;
            const int it0 = N_ITEMS_P0 + g * 16 + wid * 2;
            const TItem t0 = decode_item(a, a.ws, it0); const TItem t1 = decode_item(a, a.ws, it0 + 1);
            transpose_pair(t0, t1, true, scr, lane);
        }
    }
}
__device__ __forceinline__ void phase3b(const Args& a, LAS unsigned char* lds) {
    lru_sweep<1>(a, lds);
}

__device__ __forceinline__ void phase5(const Args& a, LAS unsigned char* lds) {
    const int tid = threadIdx.x, lane = tid & 63, wid = __builtin_amdgcn_readfirstlane(tid >> 6);
    LAS u32x4* WH = (LAS u32x4*)lds;
    LAS u32x4* WLo = (LAS u32x4*)(lds + 32768);
    LAS float* cL = (LAS float*)(lds + 65536);
    const float* mod = (const float*)(a.ws + WS_MOD); bf16_t* H2 = (bf16_t*)(a.ws + WS_H); float* aff = (float*)(a.ws + WS_AFF);
    const float* wr = a.in[I_WROUTER];
    for (int blk = blockIdx.x; blk < ML / 256; blk += gridDim.x) {
        const int b = blk >> 4, row0 = blk * 256;
        const float* sh2 = mod + b * 6144 + 3072; const float* sc2 = mod + b * 6144 + 4096;
        __syncthreads();
        for (int idx = tid; idx < 2048; idx += NTHREADS) {
            const int e = idx & 15, kq = (idx >> 4) & 3, ks = idx >> 6, k0 = 32 * ks + 8 * kq;
            float w[8], wl[8];
#pragma unroll
            for (int j = 0; j < 8; ++j) { const int d = k0 + j; w[j] = a.in[I_N2G][d] * (1.0f + sc2[d]) * wr[d * 16 + e]; }
            u32x4 hi; hi.x = pk2(w[0], w[1]); hi.y = pk2(w[2], w[3]); hi.z = pk2(w[4], w[5]); hi.w = pk2(w[6], w[7]);
            float wh[8]; unpack8(hi, wh);
#pragma unroll
            for (int j = 0; j < 8; ++j) wl[j] = w[j] - wh[j];
            u32x4 lo; lo.x = pk2(wl[0], wl[1]); lo.y = pk2(wl[2], wl[3]); lo.z = pk2(wl[4], wl[5]); lo.w = pk2(wl[6], wl[7]);
            WH[idx] = hi; WLo[idx] = lo;
        }
        if (wid == 0) {
            float ce[16];
#pragma unroll
            for (int e = 0; e < 16; ++e) ce[e] = 0.f;
            for (int i = 0; i < 16; ++i) { const int d = lane + 64 * i; const float sv = sh2[d];
#pragma unroll
                for (int e = 0; e < 16; ++e) ce[e] += sv * wr[d * 16 + e]; }
#pragma unroll
            for (int e = 0; e < 16; ++e) { const float t = wave_sum(ce[e]); if (lane == e) cL[e] = t; }
        }
        f32x4 gs[4], shv[4];
#pragma unroll
        for (int j = 0; j < 4; ++j) { const f32x4 g = *((const f32x4*)a.in[I_N2G] + lane + 64 * j), sc = *((const f32x4*)sc2 + lane + 64 * j); gs[j] = g * (sc + 1.0f); shv[j] = *((const f32x4*)sh2 + lane + 64 * j); }
        __syncthreads();
        const float cmine = cL[lane & 15];
        for (int it = 0; it < 2; ++it) {
            const int r0 = row0 + (wid * 2 + it) * 16;
            const float* xp = a.out + (size_t)(r0 + (lane & 15)) * DM + 8 * (lane >> 4);
            f32x4 acc = (f32x4){0.f, 0.f, 0.f, 0.f}; float ssq = 0.f;
#pragma unroll 1
            for (int kb = 0; kb < 4; ++kb) {
                f32x4 v[8][2];
#pragma unroll
                for (int i = 0; i < 8; ++i) { v[i][0] = *(const f32x4*)(xp + 32 * (kb * 8 + i)); v[i][1] = *(const f32x4*)(xp + 32 * (kb * 8 + i) + 4); }
#pragma unroll
                for (int i = 0; i < 8; ++i) {
                    const int ks = kb * 8 + i;
                    const float x[8] = {v[i][0].x, v[i][0].y, v[i][0].z, v[i][0].w, v[i][1].x, v[i][1].y, v[i][1].z, v[i][1].w};
#pragma unroll
                    for (int j = 0; j < 8; ++j) ssq += x[j] * x[j];
                    u32x4 hi; hi.x = pk2(x[0], x[1]); hi.y = pk2(x[2], x[3]); hi.z = pk2(x[4], x[5]); hi.w = pk2(x[6], x[7]);
                    float xh[8], xl[8]; unpack8(hi, xh);
#pragma unroll
                    for (int j = 0; j < 8; ++j) xl[j] = x[j] - xh[j];
                    u32x4 lo; lo.x = pk2(xl[0], xl[1]); lo.y = pk2(xl[2], xl[3]); lo.z = pk2(xl[4], xl[5]); lo.w = pk2(xl[6], xl[7]);
                    const bf16x8 ah = __builtin_bit_cast(bf16x8, hi), al = __builtin_bit_cast(bf16x8, lo);
                    const bf16x8 bh = __builtin_bit_cast(bf16x8, WH[ks * 64 + lane]), bl = __builtin_bit_cast(bf16x8, WLo[ks * 64 + lane]);
                    acc = __builtin_amdgcn_mfma_f32_16x16x32_bf16(ah, bh, acc, 0, 0, 0);
                    acc = __builtin_amdgcn_mfma_f32_16x16x32_bf16(al, bh, acc, 0, 0, 0);
                    acc = __builtin_amdgcn_mfma_f32_16x16x32_bf16(ah, bl, acc, 0, 0, 0);
                }
            }
            ssq += __shfl_xor(ssq, 16); ssq += __shfl_xor(ssq, 32);
            const float rstd_l = rsqrtf(ssq * (1.0f / DM) + EPSN);
#pragma unroll
            for (int rg = 0; rg < 4; ++rg) {
                const int row = 4 * (lane >> 4) + rg;
                const float rs = __shfl(rstd_l, row);
                const float lg = acc[rg] * rs + cmine;
                float mx = lg; mx = fmaxf(mx, __shfl_xor(mx, 1)); mx = fmaxf(mx, __shfl_xor(mx, 2)); mx = fmaxf(mx, __shfl_xor(mx, 4)); mx = fmaxf(mx, __shfl_xor(mx, 8));
                const float ex = expf(lg - mx);
                float sm = ex; sm += __shfl_xor(sm, 1); sm += __shfl_xor(sm, 2); sm += __shfl_xor(sm, 4); sm += __shfl_xor(sm, 8);
                const int t = (r0 + row) & 4095;
                aff[((size_t)(b * 16 + (lane & 15))) * SEQL + t] = ex / sm;
            }
#pragma unroll 1
            for (int rr = 0; rr < 16; rr += 4) {
                f32x4 hv[4][4];
#pragma unroll
                for (int q = 0; q < 4; ++q) load_row(a.out + (size_t)(r0 + rr + q) * DM, lane, hv[q]);
#pragma unroll
                for (int q = 0; q < 4; ++q) { const float rs = __shfl(rstd_l, rr + q);
#pragma unroll
                    for (int j = 0; j < 4; ++j) { const f32x4 o = (hv[q][j] * rs) * gs[j] + shv[j]; u32x2 w2; w2.x = pk2(o.x, o.y); w2.y = pk2(o.z, o.w); *((u32x2*)(H2 + (size_t)(r0 + rr + q) * DM) + lane + 64 * j) = w2; } }
            }
        }
    }
}

__device__ __forceinline__ void phase6(const Args& a, LAS unsigned char* lds) {
    const int tid = threadIdx.x, lane = tid & 63, wid = tid >> 6;
    LAS unsigned* hist = (LAS unsigned*)lds;
    LAS unsigned* selw = (LAS unsigned*)(lds + 1024);
    LAS unsigned* wtot = (LAS unsigned*)(lds + 1088);
    LAS int* selL = (LAS int*)(lds + 2048);
    const float* aff = (const float*)(a.ws + WS_AFF); const bf16_t* H2 = (const bf16_t*)(a.ws + WS_H);
    int* idx = (int*)(a.ws + WS_IDX); float* gv = (float*)(a.ws + WS_GV); bf16_t* XS = (bf16_t*)(a.ws + WS_XS); int* slotOf = (int*)(a.ws + WS_SLOT);
    for (int item = blockIdx.x; item < NB * NE; item += gridDim.x) {
        const int b = item >> 4;
        const float* ap = aff + (size_t)item * SEQL + tid * 8;
        const f32x4 f0 = *(const f32x4*)ap, f1 = *(const f32x4*)(ap + 4);
        const float fv[8] = {f0.x, f0.y, f0.z, f0.w, f1.x, f1.y, f1.z, f1.w};
        unsigned u[8];
#pragma unroll
        for (int i = 0; i < 8; ++i) u[i] = __builtin_bit_cast(unsigned, fv[i]);
        unsigned prefix = 0, mask = 0, remaining = CAP;
        for (int pass = 0; pass < 4; ++pass) {
            const int shift = 24 - 8 * pass;
            if (tid < 256) hist[tid] = 0;
            __syncthreads();
#pragma unroll
            for (int i = 0; i < 8; ++i) if ((u[i] & mask) == prefix) atomicAdd((unsigned*)&hist[(u[i] >> shift) & 255], 1u);
            __syncthreads();
            if (wid == 0) {
                unsigned c4[4]; unsigned s = 0;
#pragma unroll
                for (int j = 0; j < 4; ++j) { c4[j] = hist[255 - (4 * lane + j)]; s += c4[j]; }
                unsigned incl = s;
#pragma unroll
                for (int o = 1; o < 64; o <<= 1) { const unsigned t = __shfl_up(incl, o); if (lane >= o) incl += t; }
                const unsigned excl = incl - s;
                if (excl < remaining && remaining <= incl) {
                    unsigned run = excl; int jb = 0; unsigned rem = 0; bool found = false;
#pragma unroll
                    for (int j = 0; j < 4; ++j) { if (!found && run + c4[j] >= remaining) { jb = j; rem = remaining - run; found = true; } if (!found) run += c4[j]; }
                    selw[0] = 255 - (4 * lane + jb); selw[1] = rem;
                }
            }
            __syncthreads();
            prefix |= selw[0] << shift; mask |= 255u << shift; remaining = selw[1];
            __syncthreads();
        }
        const unsigned T = prefix;
        unsigned cg_ = 0, ce = 0;
#pragma unroll
        for (int i = 0; i < 8; ++i) { cg_ += (u[i] > T); ce += (u[i] == T); }
        const unsigned packed = cg_ | (ce << 16);
        unsigned incl = packed;
#pragma unroll
        for (int o = 1; o < 64; o <<= 1) { const unsigned t = __shfl_up(incl, o); if (lane >= o) incl += t; }
        if (lane == 63) wtot[wid] = incl;
        __syncthreads();
        unsigned base = 0;
        for (int w = 0; w < wid; ++w) base += wtot[w];
        const unsigned excl = base + incl - packed;
        unsigned gB = excl & 0xffffu, eB = excl >> 16;
#pragma unroll
        for (int i = 0; i < 8; ++i) {
            const int t = tid * 8 + i; int pos = -1;
            if (u[i] > T) { pos = (int)(gB + (eB < remaining ? eB : remaining)); ++gB; }
            else if (u[i] == T) { if (eB < remaining) pos = (int)(gB + eB); ++eB; }
            if (pos >= 0) { idx[(size_t)item * CAP + pos] = b * SEQL + t; gv[(size_t)item * CAP + pos] = fv[i]; }
            slotOf[(size_t)item * SEQL + t] = pos;
        }
        __syncthreads();
        __syncthreads();
    }
}

__device__ __forceinline__ void phase9(const Args& a) {
    const int lane = threadIdx.x & 63, wid = threadIdx.x >> 6;
    const int gw = blockIdx.x * NWAVES + wid, NGW = gridDim.x * NWAVES;
    const float* mod = (const float*)(a.ws + WS_MOD); const bf16_t* YS = (const bf16_t*)(a.ws + WS_YS); const int* slotOf = (const int*)(a.ws + WS_SLOT);
    int pn = -1;
    if (gw < ML && lane < 16) pn = slotOf[((size_t)((gw >> 12) * 16 + lane)) * SEQL + (gw & 4095)];
    for (int m = gw; m < ML; m += NGW) {
        const int b = m >> 12;
        const int myp = pn; pn = -1;
        { const int mn = m + NGW; if (mn < ML && lane < 16) pn = slotOf[((size_t)((mn >> 12) * 16 + lane)) * SEQL + (mn & 4095)]; }
        float* op = a.out + (size_t)m * DM + 8 * lane; const float* g2 = mod + b * 6144 + 5120 + 8 * lane;
        f32x4 xv[2][2], gg[2][2];
#pragma unroll
        for (int j = 0; j < 2; ++j)
#pragma unroll
            for (int q = 0; q < 2; ++q) { xv[j][q] = *(const f32x4*)(op + 512 * j + 4 * q); gg[j][q] = *(const f32x4*)(g2 + 512 * j + 4 * q); }
        float acc[2][8];
#pragma unroll
        for (int j = 0; j < 2; ++j)
#pragma unroll
            for (int i = 0; i < 8; ++i) acc[j][i] = 0.f;
        unsigned long long msk = __ballot(myp >= 0);
        while (msk) {
            const int e0 = __builtin_ctzll(msk); msk &= msk - 1;
            const bool two = msk != 0; const int e1 = two ? __builtin_ctzll(msk) : e0; if (two) msk &= msk - 1;
            const int p0 = __shfl(myp, e0), p1 = __shfl(myp, e1);
            const bf16_t* y0 = YS + ((size_t)(b * 16 + e0) * CAP + p0) * DM + 8 * lane; const bf16_t* y1 = YS + ((size_t)(b * 16 + e1) * CAP + p1) * DM + 8 * lane;
            const u32x4 r00 = *(const u32x4*)y0, r01 = *(const u32x4*)(y0 + 512), r10 = *(const u32x4*)y1, r11 = *(const u32x4*)(y1 + 512);
            const float w1 = two ? 1.f : 0.f;
            float t0[8], t1[8];
            unpack8(r00, t0); unpack8(r10, t1);
#pragma unroll
            for (int i = 0; i < 8; ++i) acc[0][i] += t0[i] + w1 * t1[i];
            unpack8(r01, t0); unpack8(r11, t1);
#pragma unroll
            for (int i = 0; i < 8; ++i) acc[1][i] += t0[i] + w1 * t1[i];
        }
#pragma unroll
        for (int j = 0; j < 2; ++j)
#pragma unroll
            for (int q = 0; q < 2; ++q) { const f32x4 av = (f32x4){acc[j][4 * q], acc[j][4 * q + 1], acc[j][4 * q + 2], acc[j][4 * q + 3]};
                *(f32x4*)(op + 512 * j + 4 * q) = xv[j][q] + gg[j][q] * av; }
    }
}


#define XB_TMO      128
#define XB_XCNT(j)  (256  + 64 * (j))
#define XB_XSUB(j)  (1280 + 64 * (j))
#define XB_XGEN(j)  (2304 + 64 * (j))
#define XB_TOP      3328
#define XB_TOPGEN   3392
#define XCD_BAR_WORDS 3456
#define XB_SPIN_CAP (1u << 18)
__device__ __forceinline__ unsigned xb_ld(unsigned* p)              { return __hip_atomic_load(p, __ATOMIC_RELAXED, __HIP_MEMORY_SCOPE_AGENT); }
__device__ __forceinline__ unsigned xb_add(unsigned* p, unsigned v) { return __hip_atomic_fetch_add(p, v, __ATOMIC_RELAXED, __HIP_MEMORY_SCOPE_AGENT); }
__device__ __forceinline__ unsigned xb_xcc_id() { return (unsigned)__builtin_amdgcn_s_getreg((3 << 11) | 20) & 0xFu; }
#define XB_SPIN(cond, bar) do { unsigned _sp = 0; while (cond) { __builtin_amdgcn_s_sleep(1); \
    if ((++_sp & 255u) == 0u) { if (xb_ld(&(bar)[XB_TMO])) break; if (_sp > XB_SPIN_CAP) { atomicAdd(&(bar)[XB_TMO], 1u); break; } } } } while (0)
struct XcdBarrier { unsigned* bar; unsigned x; volatile LAS unsigned* st; };
__device__ __forceinline__ XcdBarrier xcd_barrier_post(unsigned* bar, volatile LAS unsigned* st) {
    XcdBarrier b; b.bar = bar; b.x = xb_xcc_id(); b.st = st;
    if (threadIdx.x == 0) (void)xb_add(&bar[XB_XCNT(b.x)], 1u);
    return b;
}
__device__ __forceinline__ void xcd_barrier_complete(unsigned* bar, unsigned x, unsigned& nloc, unsigned& nx) {
    const unsigned G = gridDim.x * gridDim.y * gridDim.z;
    unsigned sum, cnt, mine, sp = 0u;
    for (;;) {
        sum = 0u; cnt = 0u; mine = 0u;
#pragma unroll
        for (unsigned j = 0; j < 16; ++j) { const unsigned c = xb_ld(&bar[XB_XCNT(j)]); sum += c; cnt += (c > 0u) ? 1u : 0u; mine = (j == x) ? c : mine; }
        if (sum == G) break;
        __builtin_amdgcn_s_sleep(1);
        if ((++sp & 255u) == 0u) { if (xb_ld(&bar[XB_TMO])) break; if (sp > XB_SPIN_CAP) { atomicAdd(&bar[XB_TMO], 1u); break; } }
    }
    nloc = mine > 0u ? mine : 1u; nx = cnt > 0u ? cnt : 1u;
}
__device__ __forceinline__ void xcd_barrier(const XcdBarrier& b) {
    asm volatile("s_waitcnt vmcnt(0)" ::: "memory");
    __syncthreads();
    if (threadIdx.x == 0) {
        unsigned* bar = b.bar;
        __builtin_amdgcn_s_waitcnt(0);
        unsigned nloc = b.st[0], nx = b.st[1];
        if (nloc == 0u) { xcd_barrier_complete(bar, b.x, nloc, nx); b.st[0] = nloc; b.st[1] = nx; }
        const unsigned old = xb_add(&bar[XB_XSUB(b.x)], 1u);
        const unsigned gen = old / nloc;
        if (old + 1u == (gen + 1u) * nloc) {
            __builtin_amdgcn_fence(__ATOMIC_RELEASE, "agent");
            asm volatile("s_waitcnt vmcnt(0)" ::: "memory");
            const unsigned og = xb_add(&bar[XB_TOP], 1u);
            const unsigned tg = og / nx;
            if (og + 1u == (tg + 1u) * nx) xb_add(&bar[XB_TOPGEN], 1u);
            else XB_SPIN(xb_ld(&bar[XB_TOPGEN]) == tg, bar);
            __builtin_amdgcn_fence(__ATOMIC_ACQUIRE, "agent");
            xb_add(&bar[XB_XGEN(b.x)], 1u);
            asm volatile("s_waitcnt vmcnt(0)" ::: "memory");
        } else {
            XB_SPIN(xb_ld(&bar[XB_XGEN(b.x)]) == gen, bar);
            __builtin_amdgcn_fence(__ATOMIC_ACQUIRE, "agent");
            asm volatile("s_waitcnt vmcnt(0)" ::: "memory");
        }
    }
    __syncthreads();
}

constexpr int NPHASE = 10;
__global__ void __launch_bounds__(NTHREADS, 2) fwd_kernel(Args args) {
    extern __shared__ __attribute__((aligned(16))) unsigned char lds_raw[];
    LAS unsigned char* lds = (LAS unsigned char*)lds_raw;
    cg::grid_group grid = cg::this_grid();
    const int lo = args.ph_lo, hi = args.ph_hi;
    unsigned char* ws = args.ws;
#ifdef ONLY_PHASE
#define IN(k) ((k)==ONLY_PHASE && lo <= (k) && (k) < hi)
#else
#define IN(k) (lo <= (k) && (k) < hi)
#endif
    { LAS unsigned* st0 = (LAS unsigned*)(lds + 147328); if (threadIdx.x < 2) st0[threadIdx.x] = 0u; __syncthreads(); }
    const XcdBarrier xbar = xcd_barrier_post((unsigned*)(ws + WS_CTL) + 4096, (volatile LAS unsigned*)(lds + 147328));
    if (args.ph_hi < 0) grid.sync();
#define SEAM(k) do { if (IN(k) && IN((k) + 1)) xcd_barrier(xbar); } while (0)
#ifndef REPEAT_MASK
#define REPEAT_MASK 0
#endif
#define REP(k, body) do { if ((REPEAT_MASK >> (k)) & 1) { grid.sync(); body; } } while (0)
    if (IN(0)) { phase0(args, lds); REP(0, phase0(args, lds)); } SEAM(0);
    if (IN(1)) { phase1(args); REP(1, phase1(args)); } SEAM(1);
    if (IN(2)) {
        pg8::Gemm g{(const bf16_t*)(ws + WS_H), (const bf16_t*)(ws + WS_WIN), MT, NIN, DM, nullptr}; pg8::Order S; S.init(MT, NIN, gridDim.x, blockIdx.x, 0, 0);
        pg8::EpiStoreBf16 E{(bf16_t*)(ws + WS_QKV), NIN, nullptr};
        pg8::gemm_phase<pg8::EpiStoreBf16>(lds, g, S, E);
        deferred_weight_copies(args, lds);
    } SEAM(2);
    if (IN(3)) { phase3a(args, lds); xcd_barrier(xbar); phase3b(args, lds); } SEAM(3);
    if (IN(4)) {
        pg8::Gemm g{(const bf16_t*)(ws + WS_AO), (const bf16_t*)(ws + WS_WOUT), ML, DM, DM, nullptr}; pg8::Order S; S.init(ML, DM, gridDim.x, blockIdx.x, 0, 0);
        pg8::EpiResid E{args.in[I_X], args.out, (const float*)(ws + WS_MOD) + 2048};
        pg8::gemm_phase<pg8::EpiResid>(lds, g, S, E);
        REP(4, pg8::gemm_phase<pg8::EpiResid>(lds, g, S, E));
    } SEAM(4);
    if (IN(5)) { phase5(args, lds); REP(5, phase5(args, lds)); } SEAM(5);
    if (IN(6)) { phase6(args, lds); REP(6, phase6(args, lds)); } SEAM(6);
    if (IN(7)) {
        pg8::Gemm g{(const bf16_t*)(ws + WS_H), (const bf16_t*)(ws + WS_WUP), MX, 2048, DM, (const int*)(ws + WS_IDX)};   pg8::Order S; S.init(MX, 2048, gridDim.x, blockIdx.x, 1, (size_t)2048 * DM * 2);
        pg8::EpiSwiGLU E{(bf16_t*)(ws + WS_HID)};
        pg8::gemm_phase<pg8::EpiSwiGLU, true, true>(lds, g, S, E);
    } SEAM(7);
    if (IN(8)) {
        pg8::Gemm g{(const bf16_t*)(ws + WS_HID), (const bf16_t*)(ws + WS_WDN), MX, DM, DM, nullptr}; pg8::Order S; S.init(MX, DM, gridDim.x, blockIdx.x, 1, (size_t)DM * DM * 2);
        pg8::EpiStoreBf16 E{(bf16_t*)(ws + WS_YS), DM, (const float*)(ws + WS_GV)};
        pg8::gemm_phase<pg8::EpiStoreBf16>(lds, g, S, E);
        REP(8, pg8::gemm_phase<pg8::EpiStoreBf16>(lds, g, S, E));
    } SEAM(8);
    if (IN(9)) { phase9(args); }
#undef IN
#undef SEAM
}

#ifndef MK_PER_PHASE
#define MK_PER_PHASE 0
#endif
extern "C" void kernel_launch(void* const* d_in, const int* in_sizes, int n_in, void* d_out, int out_size, void* d_ws, size_t ws_size, hipStream_t stream) {
    static int grid = 0;
    if (grid == 0) {
        if (n_in != 24 || out_size != ML * DM || ws_size < WS_END) { fprintf(stderr, "kernel_launch: unexpected shapes (n_in %d out %d ws %zu)\n", n_in, out_size, ws_size); grid = -1; return; }
        int dev = 0, cus = 0, per_cu = 0;
        hipGetDevice(&dev); hipDeviceGetAttribute(&cus, hipDeviceAttributeMultiprocessorCount, dev);
        if (hipFuncSetAttribute((const void*)fwd_kernel, hipFuncAttributeMaxDynamicSharedMemorySize, LDS_BYTES) != hipSuccess) { fprintf(stderr, "kernel_launch: hipFuncSetAttribute failed\n"); grid = -1; return; }
        hipOccupancyMaxActiveBlocksPerMultiprocessor(&per_cu, (const void*)fwd_kernel, NTHREADS, LDS_BYTES);
        (void)hipGetLastError();
        if (per_cu < 1) per_cu = 1;
        grid = cus;
        fprintf(stderr, "kernel_launch: grid %d (occupancy query %d/CU)\n", grid, per_cu);
    }
    if (grid < 0) return;
    hipMemsetAsync((char*)d_ws + WS_CTL, 0, 65536, stream);
    Args a{};
    for (int i = 0; i < 24; ++i) a.in[i] = (const float*)d_in[i];
    a.out = (float*)d_out; a.ws = (unsigned char*)d_ws;
#if MK_PER_PHASE
    for (int p = 0; p < NPHASE; ++p) {
        a.ph_lo = p; a.ph_hi = p + 1;
        void* kargs[] = {&a};
        hipError_t e = hipLaunchCooperativeKernel((const void*)fwd_kernel, dim3(grid), dim3(NTHREADS), kargs, LDS_BYTES, stream);
        if (e != hipSuccess) { fprintf(stderr, "kernel_launch: launch of phase %d failed: %s\n", p, hipGetErrorString(e)); break; }
    }
#else
    a.ph_lo = 0; a.ph_hi = NPHASE;
    void* kargs[] = {&a};
    hipError_t e = hipLaunchCooperativeKernel((const void*)fwd_kernel, dim3(grid), dim3(NTHREADS), kargs, LDS_BYTES, stream);
    if (e != hipSuccess) fprintf(stderr, "kernel_launch: cooperative launch failed: %s (grid %d)\n", hipGetErrorString(e), grid);
#endif
}
```

```cpp
#include <hip/hip_runtime.h>
#include <hip/hip_cooperative_groups.h>
#include <cstdio>
#include <cstdint>
namespace cg = cooperative_groups;

#define LAS __attribute__((address_space(3)))
typedef unsigned short bf16_t;
typedef short bf16x8 __attribute__((ext_vector_type(8)));
typedef short s16x4 __attribute__((ext_vector_type(4)));
typedef float f32x4 __attribute__((ext_vector_type(4)));
typedef float f32x16 __attribute__((ext_vector_type(16)));
typedef unsigned u32x4 __attribute__((ext_vector_type(4)));
typedef unsigned u32x2 __attribute__((ext_vector_type(2)));

constexpr int NB = 16, SEQL = 4096, DM = 1024, LCTX = 256, NIN = 1792;
constexpr int ML = NB * SEQL, MC = NB * LCTX, MT = ML + MC;
constexpr int NE = 16, CAP = 512, MX = NB * NE * CAP;
constexpr int NTHREADS = 512, NWAVES = 8;
constexpr float EPSN = 1e-6f;
constexpr float LOG2E = 1.4426950408889634f;

constexpr size_t MiB = 1u << 20;
constexpr size_t WS_CTL = 0, WS_MOD = 1 * MiB, WS_WIN = 2 * MiB, WS_WOUT = 6 * MiB, WS_WUP = 8 * MiB, WS_WDN = 72 * MiB, WS_AFF = 104 * MiB,
                 WS_IDX = 108 * MiB, WS_GV = 109 * MiB, WS_H = 110 * MiB, WS_QKV = 246 * MiB, WS_AO = 484 * MiB, WS_XS = 612 * MiB, WS_HF = 868 * MiB,
                 WS_SLOT = 996 * MiB, WS_END = 1000 * MiB;
constexpr size_t WS_HID = WS_QKV;
constexpr size_t WS_YS = WS_XS;
constexpr size_t WS_AGG = WS_HF;
constexpr size_t WS_LW = WS_MOD + 512 * 1024;
constexpr int LDS_BYTES = 147456;

__device__ __forceinline__ unsigned f2bf(float f) { unsigned u = __builtin_bit_cast(unsigned, f); return (u + 0x7fffu + ((u >> 16) & 1u)) >> 16; }
__device__ __forceinline__ unsigned pk2(float lo, float hi) { unsigned r; asm("v_cvt_pk_bf16_f32 %0, %1, %2" : "=v"(r) : "v"(lo), "v"(hi)); return r; }
__device__ __forceinline__ float bflo(unsigned u) { return __builtin_bit_cast(float, u << 16); }
__device__ __forceinline__ float bfhi(unsigned u) { return __builtin_bit_cast(float, u & 0xffff0000u); }
__device__ __forceinline__ float bf1(bf16_t h) { return __builtin_bit_cast(float, ((unsigned)h) << 16); }
__device__ __forceinline__ void unpack8(u32x4 r, float* o) { o[0] = bflo(r.x); o[1] = bfhi(r.x); o[2] = bflo(r.y); o[3] = bfhi(r.y); o[4] = bflo(r.z); o[5] = bfhi(r.z); o[6] = bflo(r.w); o[7] = bfhi(r.w); }
__device__ __forceinline__ bf16x8 pack8(const float* v) { u32x4 w; w.x = pk2(v[0], v[1]); w.y = pk2(v[2], v[3]); w.z = pk2(v[4], v[5]); w.w = pk2(v[6], v[7]); return __builtin_bit_cast(bf16x8, w); }
__device__ __forceinline__ float wave_sum(float v) {
#pragma unroll
    for (int o = 1; o < 64; o <<= 1) v += __shfl_xor(v, o);
    return v;
}
__device__ __forceinline__ int crow(int r, int hi) { return (r & 3) + 8 * (r >> 2) + 4 * hi; }
__device__ __forceinline__ float sigmoidf_(float x) { return 1.0f / (1.0f + __expf(-x)); }

namespace pg8 {
#define PG8_LAS __attribute__((address_space(3)))
constexpr int BM = 256, BK = 64, HALF = 128, HTB = HALF * BK * 2, STAGE_BYTES = 8 * HTB, NXCD = 8, WGM = 8;
__host__ __device__ __forceinline__ int lds_byte(int r, int c) { const int st = (r >> 4) * 2 + (c >> 5), rr = r & 15, cc = c & 31, ob = rr * 64 + cc * 2; return st * 1024 + (ob ^ (((ob >> 9) & 1) << 5)); }
__host__ __device__ __forceinline__ void stage_rc(int b, int& R, int& C) { const int st = b / 1024, sb = b % 1024, swz = sb ^ (((sb >> 9) & 1) << 5); R = (st >> 1) * 16 + swz / 64; C = (st & 1) * 32 + (swz % 64) / 2; }
__host__ __device__ __forceinline__ int perm32(int rho) { const int n = rho >> 4, i = rho & 15; return 8 * (i >> 2) + 4 * n + (i & 3); }

struct Unit { int pm, pn, e; };
struct Gemm { const bf16_t* A; const bf16_t* Bt; int M, N, K; const int* rowmap; };

struct Order {
    int nM, nN, nwg, G, c, mode; size_t bstride;
    __device__ void init(int M, int N, int G_, int c_, int mode_, size_t bstride_) { nM = M / BM; nN = N / BM; nwg = nM * nN; G = G_; c = c_; mode = mode_; bstride = bstride_; }
    __device__ bool next(int i, Unit& u) const {
        const long Lq = (long)i * G + c; if (Lq >= nwg) return false;
        int wgid = (int)Lq; { const int q = nwg / NXCD, r = nwg % NXCD, xcd = wgid % NXCD, off = wgid / NXCD; wgid = (xcd < r ? xcd * (q + 1) : r * (q + 1) + (xcd - r) * q) + off; }
        const int nig = WGM * nN, gid = wgid / nig, fm = gid * WGM, gsz = (nM - fm) < WGM ? (nM - fm) : WGM;
        int pm = fm + ((wgid % nig) % gsz); u.pn = (wgid % nig) / gsz; u.e = 0;
        if (mode == 1) { const int e = pm >> 5, b = (pm >> 1) & 15, hf = pm & 1; pm = (b * 16 + e) * 2 + hf; u.e = e; }
        u.pm = pm; return true;
    }
};

__device__ __forceinline__ unsigned cvt_pk_bf16(float lo, float hi) { unsigned r; asm volatile("v_cvt_pk_bf16_f32 %0, %1, %2" : "=v"(r) : "v"(lo), "v"(hi)); return r; }

struct EpiStoreBf16 {
    static constexpr bool PERM = true;
    bf16_t* O; int ldc; const float* rs;
    __device__ __forceinline__ void operator()(const f32x4 (&acc)[2][2][4][2], const Unit& u, int wr, int wc, int fr, int fq) const {
        const int row0 = u.pm * BM + wr * 64 + fr, col0 = u.pn * BM + wc * 32 + 8 * fq;
#pragma unroll
        for (int ai = 0; ai < 2; ++ai)
#pragma unroll
            for (int m = 0; m < 4; ++m) { const int r = row0 + ai * HALF + m * 16; const float s = rs ? rs[r] : 1.0f; bf16_t* rowp = O + (size_t)r * ldc + col0;
#pragma unroll
                for (int bj = 0; bj < 2; ++bj) { const f32x4 v0 = acc[ai][bj][m][0] * s, v1 = acc[ai][bj][m][1] * s;
                    u32x4 w; w.x = cvt_pk_bf16(v0[0], v0[1]); w.y = cvt_pk_bf16(v0[2], v0[3]); w.z = cvt_pk_bf16(v1[0], v1[1]); w.w = cvt_pk_bf16(v1[2], v1[3]);
                    *(u32x4*)(rowp + bj * HALF) = w; } }
    }
};
struct EpiResid {
    static constexpr bool PERM = false;
    const float* x; float* out; const float* gate;
    __device__ __forceinline__ void operator()(const f32x4 (&acc)[2][2][4][2], const Unit& u, int wr, int wc, int fr, int fq) const {
        const int row0 = u.pm * BM + wr * 64 + fr, col0 = u.pn * BM + wc * 32 + 4 * fq; const int b = u.pm >> 4;
        f32x4 gv[2][2];
#pragma unroll
        for (int bj = 0; bj < 2; ++bj)
#pragma unroll
            for (int n = 0; n < 2; ++n) gv[bj][n] = *(const f32x4*)(gate + (size_t)b * 6144 + col0 + bj * HALF + n * 16);
#pragma unroll
        for (int ai = 0; ai < 2; ++ai) {
            f32x4 xv[4][2][2];
#pragma unroll
            for (int m = 0; m < 4; ++m) { const size_t ro = (size_t)(row0 + ai * HALF + m * 16) * DM + col0;
#pragma unroll
                for (int bj = 0; bj < 2; ++bj)
#pragma unroll
                    for (int n = 0; n < 2; ++n) xv[m][bj][n] = __builtin_nontemporal_load((const f32x4*)(x + ro + bj * HALF + n * 16)); }
            __builtin_amdgcn_sched_barrier(0);
#pragma unroll
            for (int m = 0; m < 4; ++m) { const size_t ro = (size_t)(row0 + ai * HALF + m * 16) * DM + col0;
#pragma unroll
                for (int bj = 0; bj < 2; ++bj)
#pragma unroll
                    for (int n = 0; n < 2; ++n) *(f32x4*)(out + ro + bj * HALF + n * 16) = xv[m][bj][n] + gv[bj][n] * acc[ai][bj][m][n]; }
            __builtin_amdgcn_sched_barrier(0);
        }
    }
};
struct EpiSwiGLU {
    static constexpr bool PERM = true;
    bf16_t* O;
    __device__ __forceinline__ void operator()(const f32x4 (&acc)[2][2][4][2], const Unit& u, int wr, int wc, int fr, int fq) const {
        const int row0 = u.pm * BM + wr * 64 + fr, col0 = u.pn * HALF + wc * 32 + 8 * fq;
#pragma unroll
        for (int ai = 0; ai < 2; ++ai)
#pragma unroll
            for (int m = 0; m < 4; ++m) { bf16_t* rowp = O + (size_t)(row0 + ai * HALF + m * 16) * DM + col0; float h[8];
#pragma unroll
                for (int n = 0; n < 2; ++n)
#pragma unroll
                    for (int j = 0; j < 4; ++j) { const float g = acc[ai][0][m][n][j], up = acc[ai][1][m][n][j]; h[n * 4 + j] = g * __builtin_amdgcn_rcpf(1.0f + __expf(-g)) * up; }
                u32x4 w; w.x = cvt_pk_bf16(h[0], h[1]); w.y = cvt_pk_bf16(h[2], h[3]); w.z = cvt_pk_bf16(h[4], h[5]); w.w = cvt_pk_bf16(h[6], h[7]);
                *(u32x4*)rowp = w; }
    }
};

template <class Epi, bool ALIGN_EPI = true, bool GATHER = false>
__device__ __forceinline__ void gemm_phase(PG8_LAS unsigned char* lds, const Gemm g, const Order& S, const Epi& E) {
    const int tid = threadIdx.x, wid = __builtin_amdgcn_readfirstlane(tid >> 6), lane = tid & 63, wr = wid >> 2, wc = wid & 3, fr = lane & 15, fq = lane >> 4;
    const int K = g.K, nt = K / BK;
    unsigned voffA[2], voffB[2]; int Rr[2], Cc[2];
#pragma unroll
    for (int i = 0; i < 2; ++i) { int R, C; stage_rc(tid * 16 + i * 8192, R, C); const int Rb = Epi::PERM ? ((R & ~31) + perm32(R & 31)) : R; Rr[i] = R; Cc[i] = C;
        voffA[i] = (unsigned)(R * K + C) * 2u; voffB[i] = (unsigned)(Rb * K + C) * 2u; }
    unsigned offC[2][2], offN[2][2];
#define PG8_LOAD_OFF(dst, U) do { _Pragma("unroll") for (int _h = 0; _h < 2; ++_h) _Pragma("unroll") for (int _i = 0; _i < 2; ++_i) \
        dst[_h][_i] = (unsigned)g.rowmap[(size_t)(U).pm * BM + _h * HALF + Rr[_i]] * (unsigned)(K * 2) + (unsigned)Cc[_i] * 2u; } while (0)
#define PG8_STAGE_A(bufoff, kptr, H, NXT) do { _Pragma("unroll") for (int _i = 0; _i < 2; ++_i) { \
        const char* _p = GATHER ? ((const char*)(kptr) + ((NXT) ? offN[H][_i] : offC[H][_i])) : ((const char*)(kptr) + (size_t)(H) * hstep + voffA[_i]); \
        __builtin_amdgcn_global_load_lds((const unsigned*)_p, (PG8_LAS unsigned*)(lds + (bufoff) + ldsw + _i * 8192), 16, 0, 0); } } while (0)
    const size_t kstep = (size_t)(BK * 2);
    const size_t hstep = (size_t)HALF * K * 2;
    const size_t tstep = 2 * hstep;
    const unsigned ldsw = (unsigned)wid * 1024u;
    const int aoff = lds_byte(wr * 64 + fr, fq * 8), boff = lds_byte(wc * 32 + fr, fq * 8);
#define PG8_SA(b, h) (((b) * 2 + (h)) * HTB)
#define PG8_SB(b, h) ((4 + (b) * 2 + (h)) * HTB)
#define PG8_STAGE(bufoff, gbase, voff) do { _Pragma("unroll") for (int _i = 0; _i < 2; ++_i) \
        __builtin_amdgcn_global_load_lds((const unsigned*)((const char*)(gbase) + (voff)[_i]), (PG8_LAS unsigned*)(lds + (bufoff) + ldsw + _i * 8192), 16, 0, 0); } while (0)
#define PG8_LDA(dst, b, h) do { _Pragma("unroll") for (int m = 0; m < 4; ++m) _Pragma("unroll") for (int k = 0; k < 2; ++k) dst[m][k] = *(const PG8_LAS bf16x8*)(lds + PG8_SA(b, h) + aoff + m * 2048 + k * 1024); } while (0)
#define PG8_LDB(dst, b, h) do { _Pragma("unroll") for (int n = 0; n < 2; ++n) _Pragma("unroll") for (int k = 0; k < 2; ++k) dst[n][k] = *(const PG8_LAS bf16x8*)(lds + PG8_SB(b, h) + boff + n * 2048 + k * 1024); } while (0)
#define PG8_MMA(ai, bj, At, Bt) do { __builtin_amdgcn_s_setprio(1); _Pragma("unroll") for (int m = 0; m < 4; ++m) _Pragma("unroll") for (int n = 0; n < 2; ++n) _Pragma("unroll") for (int k = 0; k < 2; ++k) \
        acc[ai][bj][m][n] = __builtin_amdgcn_mfma_f32_16x16x32_bf16(Bt[n][k], At[m][k], acc[ai][bj][m][n], 0, 0, 0); __builtin_amdgcn_s_setprio(0); } while (0)
#define PG8_WAIT_V(n) asm volatile("s_waitcnt vmcnt(" #n ")" ::: "memory")
#define PG8_WAIT_L(n) asm volatile("s_waitcnt lgkmcnt(" #n ")" ::: "memory")
#define PG8_BAR __builtin_amdgcn_s_barrier()
#define PG8_SCHED __builtin_amdgcn_sched_barrier(0)
    Unit cur, nxt; int ui = 0;
    if (!S.next(0, cur)) return;
    f32x4 acc[2][2][4][2];
#pragma unroll
    for (int a = 0; a < 2; ++a)
#pragma unroll
        for (int b = 0; b < 2; ++b)
#pragma unroll
            for (int m = 0; m < 4; ++m)
#pragma unroll
                for (int n = 0; n < 2; ++n) acc[a][b][m][n] = (f32x4){0.f, 0.f, 0.f, 0.f};
    bf16x8 At[4][2], B0[2][2], B1[2][2];
    const char* cA = GATHER ? (const char*)g.A : (const char*)g.A + (size_t)cur.pm * tstep; const char* cB = (const char*)g.Bt + (size_t)cur.e * S.bstride + (size_t)cur.pn * tstep;
    if constexpr (GATHER) { PG8_LOAD_OFF(offC, cur); }
    PG8_STAGE(PG8_SB(0, 0), cB, voffB); PG8_STAGE(PG8_SB(0, 1), cB + hstep, voffB); PG8_STAGE_A(PG8_SA(0, 0), cA, 0, false); PG8_STAGE_A(PG8_SA(0, 1), cA, 1, false);
    if (wr == 1) PG8_BAR;
    PG8_WAIT_V(2); PG8_BAR;
    PG8_STAGE(PG8_SB(1, 0), cB + kstep, voffB); PG8_STAGE_A(PG8_SA(1, 0), cA + kstep, 0, false); PG8_STAGE(PG8_SB(1, 1), cB + hstep + kstep, voffB);
    PG8_WAIT_V(6); PG8_BAR;
    for (;;) {
        const bool has_next = S.next(ui + 1, nxt);
        if constexpr (GATHER) { if (has_next) { PG8_LOAD_OFF(offN, nxt); } else {
#pragma unroll
            for (int _h = 0; _h < 2; ++_h) { offN[_h][0] = offC[_h][0]; offN[_h][1] = offC[_h][1]; } } }
        const char* nA = GATHER ? (const char*)g.A : (has_next ? (const char*)g.A + (size_t)nxt.pm * tstep : cA); const char* nB = has_next ? (const char*)g.Bt + (size_t)nxt.e * S.bstride + (size_t)nxt.pn * tstep : cB;
        for (int t = 0; t < nt; t += 2) {
            const bool last = (t == nt - 2);
            const char* a1 = cA + (size_t)(t + 1) * kstep;
            const char* a2 = last ? nA : cA + (size_t)(t + 2) * kstep; const char* b2 = last ? nB : cB + (size_t)(t + 2) * kstep;
            const char* a3 = a2 + kstep; const char* b3 = b2 + kstep;
            PG8_LDB(B0, 0, 0); PG8_LDB(B1, 0, 1); PG8_SCHED; PG8_LDA(At, 0, 0); PG8_STAGE_A(PG8_SA(1, 1), a1, 1, false);
            PG8_WAIT_V(8); PG8_WAIT_L(0); PG8_BAR; PG8_MMA(0, 0, At, B0); PG8_MMA(0, 1, At, B1); PG8_BAR; PG8_SCHED;
            PG8_LDA(At, 0, 1); PG8_STAGE(PG8_SB(0, 0), b2, voffB); PG8_STAGE(PG8_SB(0, 1), b2 + hstep, voffB); PG8_STAGE_A(PG8_SA(0, 0), a2, 0, last);
            PG8_WAIT_V(8); PG8_WAIT_L(0); PG8_BAR; PG8_MMA(1, 0, At, B0); PG8_MMA(1, 1, At, B1); PG8_BAR; PG8_SCHED;
            PG8_LDB(B0, 1, 0); PG8_LDB(B1, 1, 1); PG8_SCHED; PG8_LDA(At, 1, 0); PG8_STAGE_A(PG8_SA(0, 1), a2, 1, last);
            PG8_WAIT_V(8); PG8_WAIT_L(0); PG8_BAR; PG8_MMA(0, 0, At, B0); PG8_MMA(0, 1, At, B1); PG8_BAR; PG8_SCHED;
            PG8_LDA(At, 1, 1); PG8_STAGE(PG8_SB(1, 0), b3, voffB); PG8_STAGE(PG8_SB(1, 1), b3 + hstep, voffB); PG8_STAGE_A(PG8_SA(1, 0), a3, 0, last);
            PG8_WAIT_V(8); PG8_WAIT_L(0); PG8_BAR; PG8_MMA(1, 0, At, B0); PG8_MMA(1, 1, At, B1); PG8_BAR; PG8_SCHED;
        }
        if constexpr (ALIGN_EPI) { if (wr == 0) PG8_BAR; }
        E(acc, cur, wr, wc, fr, fq);
        if (!has_next) break;
#pragma unroll
        for (int a = 0; a < 2; ++a)
#pragma unroll
            for (int b = 0; b < 2; ++b)
#pragma unroll
                for (int m = 0; m < 4; ++m)
#pragma unroll
                    for (int n = 0; n < 2; ++n) acc[a][b][m][n] = (f32x4){0.f, 0.f, 0.f, 0.f};
        cur = nxt; cA = nA; cB = nB; ++ui;
        if constexpr (GATHER) {
#pragma unroll
            for (int _h = 0; _h < 2; ++_h) { offC[_h][0] = offN[_h][0]; offC[_h][1] = offN[_h][1]; } }
        if constexpr (ALIGN_EPI) { if (wr == 1) PG8_BAR; }
    }
    PG8_WAIT_V(0);
    if constexpr (!ALIGN_EPI) { if (wr == 0) PG8_BAR; }
    PG8_BAR;
#undef PG8_SA
#undef PG8_SB
#undef PG8_STAGE
#undef PG8_STAGE_A
#undef PG8_LOAD_OFF
#undef PG8_LDA
#undef PG8_LDB
#undef PG8_MMA
#undef PG8_WAIT_V
#undef PG8_WAIT_L
#undef PG8_BAR
#undef PG8_SCHED
}
}

struct Args { const float* in[24]; float* out; unsigned char* ws; int ph_lo, ph_hi; };
enum { I_X = 0, I_C, I_CTX, I_CCTX, I_WADA, I_BADA, I_N1G, I_N2G, I_WIN, I_QNG, I_KNG, I_SINK, I_CONVW, I_CONVB, I_LWR, I_LBR, I_LWI, I_LBI, I_LAM, I_WOUT, I_WROUTER, I_WGATE, I_WUP, I_WDOWN };

constexpr int N_ITEMS_ALL = 16 * 56 + 16 * 32 + 3 * NE * 16 * 32;
constexpr int N_ITEMS_P0 = 16 * 56 + 16 * 32;
constexpr int DEFER_PER_WAVE = 6, N_DEFER = 144 * NWAVES * DEFER_PER_WAVE;
struct TItem { const float* W; int N, k0, n0; bf16_t* dst; };
__device__ __forceinline__ TItem decode_item(const Args& a, unsigned char* ws, int it) {
    constexpr int I_IN = 16 * 56, I_OUT = 16 * 32, I_EXP = 16 * 32;
    bf16_t* WinT = (bf16_t*)(ws + WS_WIN); bf16_t* WoutT = (bf16_t*)(ws + WS_WOUT); bf16_t* WupT = (bf16_t*)(ws + WS_WUP); bf16_t* WdnT = (bf16_t*)(ws + WS_WDN);
    TItem t; int r = it;
    if (r < I_IN) { const int kb = r / 56, nb = r % 56; t.W = a.in[I_WIN]; t.N = NIN; t.k0 = 64 * kb; t.n0 = 32 * nb; t.dst = WinT + (size_t)(32 * nb) * DM; return t; } r -= I_IN;
    if (r < I_OUT) { const int kb = r / 32, nb = r % 32; t.W = a.in[I_WOUT]; t.N = DM; t.k0 = 64 * kb; t.n0 = 32 * nb; t.dst = WoutT + (size_t)(32 * nb) * DM; return t; } r -= I_OUT;
    const int which = r / (NE * I_EXP); r -= which * NE * I_EXP;
    const int e = r / I_EXP; r -= e * I_EXP; const int kb = r / 32, nb = r % 32, n0 = 32 * nb;
    t.N = DM; t.k0 = 64 * kb; t.n0 = n0;
    if (which == 0)      { t.W = a.in[I_WGATE] + (size_t)e * DM * DM; t.dst = WupT + ((size_t)e * 2048 + 256 * (n0 >> 7) + (n0 & 127)) * DM; }
    else if (which == 1) { t.W = a.in[I_WUP] + (size_t)e * DM * DM;   t.dst = WupT + ((size_t)e * 2048 + 256 * (n0 >> 7) + 128 + (n0 & 127)) * DM; }
    else                 { t.W = a.in[I_WDOWN] + (size_t)e * DM * DM; t.dst = WdnT + ((size_t)e * 1024 + n0) * DM; }
    return t;
}
__device__ __forceinline__ void transpose_store(const TItem& t, LAS float* scr, int lane) {
    const int c = lane & 7;
#pragma unroll
    for (int j = 0; j < 4; ++j) { const int n = (lane >> 3) + 8 * j; const LAS float* s = scr + (8 * c) * 33 + n;
        u32x4 o; o.x = pk2(s[0 * 33], s[1 * 33]); o.y = pk2(s[2 * 33], s[3 * 33]); o.z = pk2(s[4 * 33], s[5 * 33]); o.w = pk2(s[6 * 33], s[7 * 33]);
        *(u32x4*)(t.dst + (size_t)n * DM + t.k0 + 8 * c) = o; }
}
__device__ __forceinline__ void transpose_pair(const TItem& t0, const TItem& t1, bool two, LAS float* scr, int lane) {
    float tv0[32], tv1[32];
#pragma unroll
    for (int i = 0; i < 32; ++i) { const int kk = 2 * i + (lane >> 5); tv0[i] = t0.W[(size_t)(t0.k0 + kk) * t0.N + t0.n0 + (lane & 31)]; }
    if (two) {
#pragma unroll
        for (int i = 0; i < 32; ++i) { const int kk = 2 * i + (lane >> 5); tv1[i] = t1.W[(size_t)(t1.k0 + kk) * t1.N + t1.n0 + (lane & 31)]; }
    }
#pragma unroll
    for (int i = 0; i < 32; ++i) { const int kk = 2 * i + (lane >> 5); scr[kk * 33 + (lane & 31)] = tv0[i]; }
    if (two) {
#pragma unroll
        for (int i = 0; i < 32; ++i) { const int kk = 2 * i + (lane >> 5); scr[2112 + kk * 33 + (lane & 31)] = tv1[i]; }
    }
    asm volatile("s_waitcnt lgkmcnt(0)" ::: "memory");
    transpose_store(t0, scr, lane);
    if (two) transpose_store(t1, scr + 2112, lane);
    asm volatile("s_waitcnt lgkmcnt(0)" ::: "memory");
}

__device__ __forceinline__ void phase0(const Args& a, LAS unsigned char* lds) {
    const int tid = threadIdx.x, lane = tid & 63, wid = tid >> 6;
    unsigned char* ws = a.ws;
    if (blockIdx.x < 48) {
        const int item = blockIdx.x;
        LAS float* sc = (LAS float*)lds;
        LAS float* accL = (LAS float*)(lds + 17 * 1024 * 4);
        for (int i = tid; i < 17 * 1024; i += NTHREADS) { const int r = i >> 10, k = i & 1023; const float v = (r < 16) ? a.in[I_C][r * 1024 + k] : a.in[I_CCTX][k]; sc[i] = v / (1.0f + __expf(-v)); }
        for (int i = tid; i < 17 * 128; i += NTHREADS) accL[i] = 0.f;
        __syncthreads();
        const int kg = tid >> 5, cl = tid & 31;
        f32x4 acc[17];
#pragma unroll
        for (int r = 0; r < 17; ++r) acc[r] = (f32x4){0.f, 0.f, 0.f, 0.f};
        const float* wp = a.in[I_WADA] + (size_t)(kg * 64) * 6144 + item * 128 + 4 * cl;
        for (int k8 = 0; k8 < 64; k8 += 8) {
            f32x4 w[8];
#pragma unroll
            for (int u = 0; u < 8; ++u) w[u] = *(const f32x4*)(wp + (size_t)(k8 + u) * 6144);
#pragma unroll
            for (int u = 0; u < 8; ++u)
#pragma unroll
                for (int r = 0; r < 17; ++r) acc[r] += w[u] * sc[r * 1024 + kg * 64 + k8 + u];
        }
        for (int round = 0; round < 16; ++round) {
            if (kg == round) {
#pragma unroll
                for (int r = 0; r < 17; ++r) { LAS f32x4* p = (LAS f32x4*)(accL + r * 128 + 4 * cl); *p = *p + acc[r]; }
            }
            __syncthreads();
        }
        float* mod = (float*)(ws + WS_MOD);
        for (int i = tid; i < 17 * 128; i += NTHREADS) { const int r = i >> 7, cc = i & 127; mod[r * 6144 + item * 128 + cc] = accL[i] + a.in[I_BADA][item * 128 + cc]; }
        __syncthreads();
    }
    for (int f = blockIdx.x * NTHREADS + tid; f < 16384; f += gridDim.x * NTHREADS) {
        const int ln = f & 63, s = (f >> 6) & 3, ct = (f >> 8) & 1, mat = (f >> 9) & 1, dn = f >> 10;
        const float* w = a.in[mat ? I_LWI : I_LWR] + (size_t)dn * 4096 + ct * 32 + (ln & 31);
        float t8[8];
#pragma unroll
        for (int jj = 0; jj < 8; ++jj) t8[jj] = w[(16 * s + 8 * (ln >> 5) + jj) * 64];
        *(bf16x8*)(ws + WS_LW + (size_t)f * 16) = pack8(t8);
    }
    LAS float* scr = (LAS float*)(lds + wid * 16896);
    const int gw = blockIdx.x * NWAVES + wid, NGW = gridDim.x * NWAVES;
    const int NITEMS = (gridDim.x == 256) ? N_ITEMS_P0 : N_ITEMS_ALL;
    for (int it = gw; it < NITEMS; it += 2 * NGW) {
        const bool two = (it + NGW) < NITEMS;
        const TItem t0 = decode_item(a, ws, it); const TItem t1 = decode_item(a, ws, two ? it + NGW : it);
        transpose_pair(t0, t1, two, scr, lane);
    }
}

__device__ __forceinline__ void deferred_weight_copies(const Args& a, LAS unsigned char* lds) {
    if (gridDim.x != 256 || blockIdx.x < 112) return;
    const int lane = threadIdx.x & 63, wid = threadIdx.x >> 6;
    LAS float* scr = (LAS float*)(lds + wid * 16896);
    const int w = (blockIdx.x - 112) * NWAVES + wid;
    const int base = N_ITEMS_ALL - N_DEFER + w * DEFER_PER_WAVE;
#pragma unroll 1
    for (int i = 0; i < DEFER_PER_WAVE; i += 2) {
        const TItem t0 = decode_item(a, a.ws, base + i); const TItem t1 = decode_item(a, a.ws, base + i + 1);
        transpose_pair(t0, t1, true, scr, lane);
    }
}

__device__ __forceinline__ void load_row(const float* src, int lane, f32x4* v) {
#pragma unroll
    for (int j = 0; j < 4; ++j) v[j] = *((const f32x4*)src + lane + 64 * j);
}
__device__ __forceinline__ void norm_mod_vals(const f32x4* v, const float* gn, const float* shift, const float* scale, bf16_t* dst, int lane, f32x4* keep) {
    float s = 0.f;
#pragma unroll
    for (int j = 0; j < 4; ++j) s += (v[j].x * v[j].x + v[j].y * v[j].y) + (v[j].z * v[j].z + v[j].w * v[j].w);
    const float rstd = rsqrtf(wave_sum(s) * (1.0f / DM) + EPSN);
#pragma unroll
    for (int j = 0; j < 4; ++j) {
        const f32x4 g = *((const f32x4*)gn + lane + 64 * j), sh = *((const f32x4*)shift + lane + 64 * j), sc = *((const f32x4*)scale + lane + 64 * j);
        const f32x4 o = (v[j] * rstd * g) * (sc + 1.0f) + sh;
        if (keep) keep[j] = o;
        u32x2 w; w.x = pk2(o.x, o.y); w.y = pk2(o.z, o.w);
        *((u32x2*)dst + lane + 64 * j) = w;
    }
}
__device__ __forceinline__ const float* p1_src(const Args& a, int m) { return (m < ML) ? a.in[I_X] + (size_t)m * DM : a.in[I_CTX] + (size_t)(m - ML) * DM; }
__device__ __forceinline__ void phase1(const Args& a) {
    const int lane = threadIdx.x & 63, wid = threadIdx.x >> 6;
    const int gw = blockIdx.x * NWAVES + wid, NGW = gridDim.x * NWAVES;
    const float* mod = (const float*)(a.ws + WS_MOD); bf16_t* H = (bf16_t*)(a.ws + WS_H);
    for (int m0 = gw; m0 < MT; m0 += 4 * NGW) {
        f32x4 v[4][4];
#pragma unroll
        for (int r = 0; r < 4; ++r) { const int m = m0 + r * NGW;
            if (m < MT) { const float* src = p1_src(a, m);
#pragma unroll
                for (int j = 0; j < 4; ++j) v[r][j] = __builtin_nontemporal_load((const f32x4*)src + lane + 64 * j); } }
#pragma unroll
        for (int r = 0; r < 4; ++r) { const int m = m0 + r * NGW;
            if (m < MT) { const int mr = (m < ML) ? (m >> 12) : 16; norm_mod_vals(v[r], a.in[I_N1G], mod + mr * 6144, mod + mr * 6144 + 1024, H + (size_t)m * DM, lane, nullptr); } }
    }
}

__device__ __forceinline__ void attn_unit(const Args& a, LAS unsigned char* lds, int unit) {
    int tid_ = threadIdx.x; asm volatile("" : "+v"(tid_));
    const int tid = tid_, lane = tid & 63, wid = __builtin_amdgcn_readfirstlane(tid >> 6), r32 = lane & 31, hi = lane >> 5;
    const int b = unit >> 6, hk = (unit >> 5) & 1, qb = unit & 31;
    const int g = wid >> 1, hq = hk * 4 + g, qhalf = wid & 1;
    const bf16_t* QKV = (const bf16_t*)(a.ws + WS_QKV);
    bf16_t* AO = (bf16_t*)(a.ws + WS_AO);
    LAS unsigned char* Kl = lds;
    LAS unsigned char* Vl = lds + 16384;
    const float FR = 0.8304820237218406f;
    bf16x8 qf[2][4];
#pragma unroll
    for (int qt = 0; qt < 2; ++qt) {
        const int t = qb * 128 + qhalf * 64 + qt * 32 + r32;
        const bf16_t* qp = QKV + (size_t)(b * SEQL + t) * NIN + hq * 64 + 8 * hi;
        float x[4][8]; float ss = 0.f;
#pragma unroll
        for (int s = 0; s < 4; ++s) { unpack8(*(const u32x4*)(qp + 16 * s), x[s]);
#pragma unroll
            for (int j = 0; j < 8; ++j) ss += x[s][j] * x[s][j]; }
        ss += __shfl_xor(ss, 32);
        const float rstd = rsqrtf(ss * (1.0f / 64.0f) + EPSN);
#pragma unroll
        for (int s = 0; s < 4; ++s)
#pragma unroll
            for (int j = 0; j < 8; ++j) x[s][j] *= rstd * a.in[I_QNG][16 * s + 8 * hi + j];
        const float prow = (float)(t >> 6), pcol = (float)(t & 63);
        const float C2 = 0.125f * LOG2E;
#pragma unroll
        for (int j = 0; j < 8; ++j) {
            const float invf = exp2f(-(float)(8 * hi + j) * FR);
            float sn, cs;
            sn = __sinf(prow * invf); cs = __cosf(prow * invf);
            { const float x1 = x[0][j], x2 = x[1][j]; x[0][j] = (x1 * cs - x2 * sn) * C2; x[1][j] = (x2 * cs + x1 * sn) * C2; }
            sn = __sinf(pcol * invf); cs = __cosf(pcol * invf);
            { const float x1 = x[2][j], x2 = x[3][j]; x[2][j] = (x1 * cs - x2 * sn) * C2; x[3][j] = (x2 * cs + x1 * sn) * C2; }
        }
#pragma unroll
        for (int s = 0; s < 4; ++s) qf[qt][s] = pack8(x[s]);
    }
    float mrun[2], lsum[2]; f32x16 O[2][2];
    float sinit; bool fixedref;
    { const float sk = a.in[I_SINK][hq] * LOG2E;
      float gq = fabsf(a.in[I_QNG][lane]), gk = fabsf(a.in[I_KNG][lane]);
#pragma unroll
      for (int o = 1; o < 64; o <<= 1) { gq = fmaxf(gq, __shfl_xor(gq, o)); gk = fmaxf(gk, __shfl_xor(gk, o)); }
      const float mref = fmaxf(8.0f * gq * gk * LOG2E * 1.02f + 0.01f, sk);
      fixedref = mref < 64.0f; sinit = fixedref ? -mref : 0.f;
#pragma unroll
      for (int qt = 0; qt < 2; ++qt) { mrun[qt] = sk; lsum[qt] = hi ? 0.f : (fixedref ? __builtin_amdgcn_exp2f(sk - mref) : 1.f); O[qt][0] = f32x16{}; O[qt][1] = f32x16{}; } }

    const int skey = tid >> 2, sp = tid & 3, sa = sp >> 1, sfh = sp & 1;
#define CHUNK_VALID(cc) ((cc) < 2 || ((qb - 1 + ((cc) - 2)) >= 0 && (qb - 1 + ((cc) - 2)) <= 31))
#define CHUNK_ROW0(cc) ((cc) < 2 ? ((size_t)ML + b * LCTX + (cc) * 128) : ((size_t)b * SEQL + (qb - 1 + ((cc) - 2)) * 128))
#define LOAD_KV(cc) do { const size_t kr_ = CHUNK_ROW0(cc) + skey; const bf16_t* kp_ = QKV + kr_ * NIN + 512 + hk * 64 + sa * 32 + 8 * sfh; pk1 = *(const u32x4*)kp_; pk2_ = *(const u32x4*)(kp_ + 16); \
        const bf16_t* vp_ = QKV + kr_ * NIN + 640 + hk * 64 + 16 * sp; pv0 = *(const u32x4*)vp_; pv1 = *(const u32x4*)(vp_ + 8); } while (0)
    u32x4 pk1, pk2_, pv0, pv1;
    LOAD_KV(0);
    for (int c = 0; c < 5; ++c) {
        if (!CHUNK_VALID(c)) continue;
        const int kb = (c < 2) ? 0 : qb - 1 + (c - 2);
        __syncthreads();
        {
            int sfh_ = sfh, sa_ = sa; asm volatile("" : "+v"(sfh_), "+v"(sa_));
            float x1[8], x2[8]; unpack8(pk1, x1); unpack8(pk2_, x2);
            const u32x4 v0 = pv0, v1 = pv1;
            { int cn = c + 1; if (cn < 5 && !CHUNK_VALID(cn)) ++cn; if (cn < 5 && CHUNK_VALID(cn)) LOAD_KV(cn); }
            float ss = 0.f;
#pragma unroll
            for (int j = 0; j < 8; ++j) ss += x1[j] * x1[j] + x2[j] * x2[j];
            ss += __shfl_xor(ss, 1); ss += __shfl_xor(ss, 2);
            const float rstd = rsqrtf(ss * (1.0f / 64.0f) + EPSN);
            const int tk = kb * 128 + skey; const float pos = sa ? (float)(tk & 63) : (float)(tk >> 6);
#pragma unroll
            for (int j = 0; j < 8; ++j) {
                float v1_ = x1[j] * rstd * a.in[I_KNG][sa_ * 32 + 8 * sfh_ + j], v2_ = x2[j] * rstd * a.in[I_KNG][sa_ * 32 + 16 + 8 * sfh_ + j];
                if (c >= 2) { const float ang = pos * __builtin_amdgcn_exp2f(-(float)(8 * sfh_ + j) * FR); const float sn = __sinf(ang), cs = __cosf(ang); const float o1 = v1_ * cs - v2_ * sn, o2 = v2_ * cs + v1_ * sn; v1_ = o1; v2_ = o2; }
                x1[j] = v1_; x2[j] = v2_;
            }
            *(LAS bf16x8*)(Kl + (4 * sa + sfh) * 2048 + skey * 16) = pack8(x1);
            *(LAS bf16x8*)(Kl + (4 * sa + 2 + sfh) * 2048 + skey * 16) = pack8(x2);
            *(LAS u32x4*)(Vl + (sp >> 1) * 8192 + skey * 64 + (sp & 1) * 32) = v0;
            *(LAS u32x4*)(Vl + (sp >> 1) * 8192 + skey * 64 + (sp & 1) * 32 + 16) = v1;
        }
        __syncthreads();
        for (int kt = 0; kt < 4; ++kt) {
            if (c == 2 && kt < qhalf * 2) continue;
            if (c == 4 && kt > qhalf * 2 + 1) continue;
            bf16x8 kf[4];
#pragma unroll
            for (int s = 0; s < 4; ++s) kf[s] = *(const LAS bf16x8*)(Kl + (2 * s + hi) * 2048 + (kt * 32 + r32) * 16);
            bf16x8 pf[2][2];
#pragma unroll
            for (int qt = 0; qt < 2; ++qt) {
                f32x16 S;
#pragma unroll
                for (int r = 0; r < 16; ++r) S[r] = sinit;
#pragma unroll
                for (int s = 0; s < 4; ++s) S = __builtin_amdgcn_mfma_f32_32x32x16_bf16(kf[s], qf[qt][s], S, 0, 0, 0);
                const int qq = qhalf * 64 + qt * 32 + r32;
                if (c == 2) {
#pragma unroll
                    for (int r = 0; r < 16; ++r) { const int kk = kt * 32 + crow(r, hi); if (kk < qq) S[r] = -1e30f; }
                } else if (c == 4) {
#pragma unroll
                    for (int r = 0; r < 16; ++r) { const int kk = kt * 32 + crow(r, hi); if (kk > qq) S[r] = -1e30f; }
                }
                if (fixedref) {
                    float ps = 0.f;
#pragma unroll
                    for (int r = 0; r < 16; ++r) { S[r] = __builtin_amdgcn_exp2f(S[r]); ps += S[r]; }
                    lsum[qt] += ps;
                } else {
                    float mx = S[0];
#pragma unroll
                    for (int r = 1; r < 16; ++r) mx = fmaxf(mx, S[r]);
                    mx = fmaxf(mx, __shfl_xor(mx, 32));
                    const float mnew = fmaxf(mrun[qt], mx), alpha = __builtin_amdgcn_exp2f(mrun[qt] - mnew);
                    mrun[qt] = mnew;
                    float ps = 0.f;
#pragma unroll
                    for (int r = 0; r < 16; ++r) { S[r] = __builtin_amdgcn_exp2f(S[r] - mnew); ps += S[r]; }
                    lsum[qt] = lsum[qt] * alpha + ps;
#pragma unroll
                    for (int r = 0; r < 16; ++r) { O[qt][0][r] *= alpha; O[qt][1][r] *= alpha; }
                }
#pragma unroll
                for (int s2 = 0; s2 < 2; ++s2) { u32x4 w; w.x = pg8::cvt_pk_bf16(S[8 * s2 + 0], S[8 * s2 + 1]); w.y = pg8::cvt_pk_bf16(S[8 * s2 + 2], S[8 * s2 + 3]); w.z = pg8::cvt_pk_bf16(S[8 * s2 + 4], S[8 * s2 + 5]); w.w = pg8::cvt_pk_bf16(S[8 * s2 + 6], S[8 * s2 + 7]); pf[qt][s2] = __builtin_bit_cast(bf16x8, w); }
            }
            const int gi = lane >> 4, li = lane & 15;
#pragma unroll
            for (int dt = 0; dt < 2; ++dt)
#pragma unroll
                for (int s2 = 0; s2 < 2; ++s2) {
                    const LAS unsigned char* vpz = Vl + dt * 8192 + (kt * 32 + 16 * s2 + 4 * hi + (li >> 2)) * 64 + (16 * (gi & 1) + 4 * (li & 3)) * 2;
                    const s16x4 lo = __builtin_bit_cast(s16x4, __builtin_amdgcn_ds_read_tr16_b64_v4i16((LAS s16x4*)vpz));
                    const s16x4 hh = __builtin_bit_cast(s16x4, __builtin_amdgcn_ds_read_tr16_b64_v4i16((LAS s16x4*)(vpz + 512)));
                    const bf16x8 vf = (bf16x8){lo[0], lo[1], lo[2], lo[3], hh[0], hh[1], hh[2], hh[3]};
#pragma unroll
                    for (int qt = 0; qt < 2; ++qt) O[qt][dt] = __builtin_amdgcn_mfma_f32_32x32x16_bf16(vf, pf[qt][s2], O[qt][dt], 0, 0, 0);
                }
        }
    }
#pragma unroll
    for (int qt = 0; qt < 2; ++qt) {
        const float l = lsum[qt] + __shfl_xor(lsum[qt], 32), inv = 1.0f / l;
        const int t = qb * 128 + qhalf * 64 + qt * 32 + r32;
        bf16_t* op = AO + (size_t)(b * SEQL + t) * DM + hq * 64;
#pragma unroll
        for (int dt = 0; dt < 2; ++dt)
#pragma unroll
            for (int rr = 0; rr < 4; ++rr) { u32x2 w; w.x = pk2(O[qt][dt][4 * rr] * inv, O[qt][dt][4 * rr + 1] * inv); w.y = pk2(O[qt][dt][4 * rr + 2] * inv, O[qt][dt][4 * rr + 3] * inv);
                *(u32x2*)(op + 32 * dt + 8 * rr + 4 * hi) = w; }
    }
}

__device__ __forceinline__ float gelu_tanh(float x) { const float u = 0.7978845608028654f * (x + 0.044715f * x * x * x); const float t = 1.0f - 2.0f / (1.0f + __expf(2.0f * u)); return 0.5f * x * (1.0f + t); }
__device__ __forceinline__ float fast_sigmoid(float x) { return __builtin_amdgcn_rcpf(1.0f + __builtin_amdgcn_exp2f(-x * LOG2E)); }
__device__ __forceinline__ float gelu_fast(float x) { const float u = 0.7978845608028654f * (x + 0.044715f * x * x * x); const float t = 1.0f - 2.0f * __builtin_amdgcn_rcpf(1.0f + __builtin_amdgcn_exp2f(2.0f * LOG2E * u)); return 0.5f * x * (1.0f + t); }
template <int MODE>
__device__ __forceinline__ void lru_phase(const Args& a, LAS unsigned char* lds) {
    const int tid = threadIdx.x, lane = tid & 63, wid = __builtin_amdgcn_readfirstlane(tid >> 6), r32 = lane & 31, hi = lane >> 5;
    const bf16_t* QKV = (const bf16_t*)(a.ws + WS_QKV);
    bf16_t* AO = (bf16_t*)(a.ws + WS_AO);
    float* AGG = (float*)(a.ws + WS_AGG);
    const u32x4* LW = (const u32x4*)(a.ws + WS_LW);
    LAS float* xcf = (LAS float*)lds;
    LAS u32x4* wL = (LAS u32x4*)(lds + 34816);
    LAS bf16_t* grL = (LAS bf16_t*)(lds + 67584);
    LAS float* wtA = (LAS float*)(lds + 83968);
    LAS float* wtB = (LAS float*)(lds + 86016);
    LAS float* cwL = (LAS float*)(lds + 88064);
    LAS float* carL = (LAS float*)(lds + 89344);
    LAS float* stg = (LAS float*)(lds + 100352);
    const int tt = wid & 3, ct = wid >> 2;
    const int ctok = tid >> 2, ccg = tid & 3;
    const int jch = ct * 32 + r32;
    for (int v = blockIdx.x; v < 256; v += gridDim.x) {
        const int n = v & 7, b = v >> 4, half = (v >> 3) & 1;
        const int ch0 = n * 64 + 16 * ccg;
        __syncthreads();
        if (tid < 320) { const int r = tid >> 6, c = tid & 63; cwL[tid] = (r < 4) ? a.in[I_CONVW][r * 512 + n * 64 + c] : a.in[I_CONVB][n * 64 + c]; }
        for (int i = tid; i < 2048; i += NTHREADS) wL[i] = LW[(size_t)(((i >> 10) * 8 + n) * 1024) + (i & 1023)];
        float nbr[2], nbi[2], c8[2];
#pragma unroll
        for (int dir = 0; dir < 2; ++dir) {
            const int chj = n * 64 + jch;
            nbr[dir] = -a.in[I_LBR][dir * 512 + chj] * LOG2E; nbi[dir] = -a.in[I_LBI][dir * 512 + chj] * LOG2E;
            const float lam = a.in[I_LAM][dir * 512 + chj];
            c8[dir] = -8.0f * ((lam > 15.f) ? __expf(-lam) : log1pf(__expf(-lam)));
        }
        if (MODE == 1) {
            const float* ag = AGG + ((size_t)((b * 8 + n) * 2) * 34) * 128;
            for (int i = tid; i < 2 * 34 * 32; i += NTHREADS) *(LAS f32x4*)(stg + 4 * i) = *(const f32x4*)(ag + 4 * i);
            __syncthreads();
            if (tid < 128) { const int dir = wid, c = lane; const LAS float* al = stg + dir * 34 * 128 + c;
                float h = 0.f;
                for (int s2 = 0; s2 < 34; ++s2) { const int T = dir ? 33 - s2 : s2 - 2; const int k = T - 16 * half;
                    if (s2 >= 2 && k >= 0 && k < 16) carL[(dir * 17 + k) * 64 + c] = h;
                    if (dir == (half ? 0 : 1) && s2 >= 2 && k >= 0 && k < 16) break;
                    h = al[s2 * 128] * h + al[s2 * 128 + 64]; } }
        }
        __syncthreads();
        const int NT = (MODE == 0) ? 17 : 16;
        u32x4 xin[4][2], gin[2];
#define LOAD_INPUTS(TL) do { const int tl_ = (TL); const bool isctx_ = tl_ < 2; const int tile_ = isctx_ ? tl_ : tl_ - 2; const int LS_ = isctx_ ? LCTX : SEQL; \
            const size_t rowbase_ = isctx_ ? ((size_t)ML + b * LCTX) : ((size_t)b * SEQL); const int tok_ = tile_ * 128 + ctok; \
            _Pragma("unroll") for (int j = 0; j < 4; ++j) { const int tj = tok_ + j - 2; \
                if (tj >= 0 && tj < LS_) { const bf16_t* xp = QKV + (rowbase_ + tj) * NIN + 768 + ch0; xin[j][0] = *(const u32x4*)xp; xin[j][1] = *(const u32x4*)(xp + 8); } \
                else { xin[j][0] = (u32x4){0u, 0u, 0u, 0u}; xin[j][1] = (u32x4){0u, 0u, 0u, 0u}; } } \
            if (MODE == 1) { const bf16_t* gp = QKV + (rowbase_ + tok_) * NIN + 1280 + ch0; gin[0] = *(const u32x4*)gp; gin[1] = *(const u32x4*)(gp + 8); } } while (0)
        const int tl0 = (MODE == 0) ? 17 * half : 2 + 16 * half;
        const bool desc = (MODE == 1) && (half == 0);
        LOAD_INPUTS(desc ? tl0 + NT - 1 : tl0);
        for (int i = 0; i < NT; ++i) {
            const int k = desc ? NT - 1 - i : i;
            const int tl = tl0 + k;
            const bool isctx = tl < 2; const int tile = isctx ? tl : tl - 2;
            const size_t rowbase = isctx ? ((size_t)ML + b * LCTX) : ((size_t)b * SEQL);
            const int t0 = tile * 128;
            {
                float acc[16];
#pragma unroll
                for (int q = 0; q < 4; ++q) { const f32x4 bv = *(const LAS f32x4*)(cwL + 4 * 64 + 16 * ccg + 4 * q); acc[4 * q] = bv.x; acc[4 * q + 1] = bv.y; acc[4 * q + 2] = bv.z; acc[4 * q + 3] = bv.w; }
#pragma unroll
                for (int j = 0; j < 4; ++j) { float xv[16]; unpack8(xin[j][0], xv); unpack8(xin[j][1], xv + 8);
#pragma unroll
                    for (int q = 0; q < 4; ++q) { const f32x4 wv = *(const LAS f32x4*)(cwL + j * 64 + 16 * ccg + 4 * q);
                        acc[4 * q] += wv.x * xv[4 * q]; acc[4 * q + 1] += wv.y * xv[4 * q + 1]; acc[4 * q + 2] += wv.z * xv[4 * q + 2]; acc[4 * q + 3] += wv.w * xv[4 * q + 3]; } }
#pragma unroll
                for (int q = 0; q < 4; ++q) *(LAS f32x4*)(xcf + ctok * 68 + 16 * ccg + 4 * q) = (f32x4){acc[4 * q], acc[4 * q + 1], acc[4 * q + 2], acc[4 * q + 3]};
                if (MODE == 1) { *(LAS u32x4*)(grL + ctok * 64 + 16 * ccg) = gin[0]; *(LAS u32x4*)(grL + ctok * 64 + 16 * ccg + 8) = gin[1]; }
            }
            if (i + 1 < NT) LOAD_INPUTS(desc ? tl - 1 : tl + 1);
            __syncthreads();
            LAS float* hfL = stg;
#pragma unroll
            for (int dir = 0; dir < 2; ++dir) {
                if (MODE == 0 && dir == 0 && tl >= 18) continue;
                if (MODE == 0 && dir == 1 && tl >= 2 && tl <= 17) continue;
                float av[16], bv[16];
                {
                    f32x16 accR = f32x16{}, accI = f32x16{};
#pragma unroll
                    for (int s = 0; s < 4; ++s) { const LAS float* xp = xcf + (tt * 32 + r32) * 68 + 16 * s + 8 * hi; const f32x4 p0 = *(const LAS f32x4*)xp, p1 = *(const LAS f32x4*)(xp + 4);
                        float t8[8] = {p0.x, p0.y, p0.z, p0.w, p1.x, p1.y, p1.z, p1.w}; const bf16x8 af = pack8(t8);
                        const bf16x8 wrf = __builtin_bit_cast(bf16x8, wL[(((dir * 2 + 0) * 2 + ct) * 4 + s) * 64 + lane]), wif = __builtin_bit_cast(bf16x8, wL[(((dir * 2 + 1) * 2 + ct) * 4 + s) * 64 + lane]);
                        accR = __builtin_amdgcn_mfma_f32_32x32x16_bf16(af, wrf, accR, 0, 0, 0); accI = __builtin_amdgcn_mfma_f32_32x32x16_bf16(af, wif, accI, 0, 0, 0); }
                    const float cc8 = c8[dir], nr = nbr[dir], ni = nbi[dir];
#define LRU_GATE_LOOP(FALLBACK) _Pragma("unroll") for (int r = 0; r < 16; ++r) { const int tau = tt * 32 + crow(r, hi); \
                        const float rg = __builtin_amdgcn_rcpf(1.0f + __builtin_amdgcn_exp2f(__builtin_fmaf(accR[r], -LOG2E, nr))), ig = __builtin_amdgcn_rcpf(1.0f + __builtin_amdgcn_exp2f(__builtin_fmaf(accI[r], -LOG2E, ni))), xv = xcf[tau * 68 + jch]; \
                        const float log_a = cc8 * rg; av[r] = __builtin_amdgcn_exp2f(log_a * LOG2E); \
                        const float x2 = 2.0f * log_a; \
                        float om = -x2 * (1.0f + x2 * (0.5f + x2 * (0.16666667f + x2 * (0.041666668f + x2 * 0.008333334f)))); \
                        if (FALLBACK) { if (x2 <= -0.25f) om = 1.0f - __builtin_amdgcn_exp2f(x2 * LOG2E); } \
                        bv[r] = __builtin_amdgcn_sqrtf(om) * ig * xv; }
                    if (__builtin_expect(__any(-2.0f * cc8 >= 0.25f), 0)) { LRU_GATE_LOOP(true) } else { LRU_GATE_LOOP(false) }
#undef LRU_GATE_LOOP
                }
                float QA[8], QB[8];
                {
                    float qa[4], qb[4];
#pragma unroll
                    for (int g = 0; g < 4; ++g) { float A = 1.f, Bq = 0.f;
#pragma unroll
                        for (int ee = 0; ee < 4; ++ee) { const int r = 4 * g + (dir ? 3 - ee : ee); Bq = av[r] * Bq + bv[r]; A *= av[r]; }
                        qa[g] = A; qb[g] = Bq; }
#pragma unroll
                    for (int g = 0; g < 4; ++g) { const float pa = __shfl_xor(qa[g], 32), pb = __shfl_xor(qb[g], 32);
                        QA[2 * g] = hi ? pa : qa[g]; QA[2 * g + 1] = hi ? qa[g] : pa; QB[2 * g] = hi ? pb : qb[g]; QB[2 * g + 1] = hi ? qb[g] : pb; }
                }
                {
                    float AW = 1.f, BW = 0.f;
#pragma unroll
                    for (int qq = 0; qq < 8; ++qq) { const int q = dir ? 7 - qq : qq; BW = QA[q] * BW + QB[q]; AW *= QA[q]; }
                    if (hi == 0) { wtA[(dir * 4 + tt) * 64 + jch] = AW; wtB[(dir * 4 + tt) * 64 + jch] = BW; }
                }
                __syncthreads();
                if (MODE == 0) {
                    if (tt == 0 && hi == 0) { float A = 1.f, Bt = 0.f;
#pragma unroll
                        for (int ww = 0; ww < 4; ++ww) { const int w = dir ? 3 - ww : ww; const float sa = wtA[(dir * 4 + w) * 64 + jch], sb = wtB[(dir * 4 + w) * 64 + jch]; Bt = sa * Bt + sb; A *= sa; }
                        const int sig = isctx ? (dir ? 1 - tl : tl) : (dir ? 2 + 31 - tile : 2 + tile);
                        float* ag = AGG + ((size_t)((b * 8 + n) * 2 + dir) * 34 + sig) * 128 + jch; ag[0] = A; ag[64] = Bt; }
                } else {
                    float h = carL[(dir * 17 + k) * 64 + jch];
#pragma unroll
                    for (int ww = 0; ww < 4; ++ww) { const int w = dir ? 3 - ww : ww; const float sa = wtA[(dir * 4 + w) * 64 + jch], sb = wtB[(dir * 4 + w) * 64 + jch];
                        if (dir ? (w > tt) : (w < tt)) h = sa * h + sb; }
                    float hin[4] = {0.f, 0.f, 0.f, 0.f};
#pragma unroll
                    for (int qq = 0; qq < 8; ++qq) { const int q = dir ? 7 - qq : qq; hin[q >> 1] = ((q & 1) == hi) ? h : hin[q >> 1]; h = QA[q] * h + QB[q]; }
                    if (dir == (desc ? 1 : 0) && tt == (desc ? 0 : 3) && hi == 0 && i + 1 < NT) carL[(dir * 17 + (desc ? k - 1 : k + 1)) * 64 + jch] = h;
#pragma unroll
                    for (int g = 0; g < 4; ++g) { float hc = hin[g];
#pragma unroll
                        for (int ee = 0; ee < 4; ++ee) { const int r = 4 * g + (dir ? 3 - ee : ee); hc = av[r] * hc + bv[r];
                            const int tau = tt * 32 + crow(r, hi);
                            if (dir == 0) hfL[tau * 64 + jch] = hc;
                            else xcf[tau * 68 + jch] = (hfL[tau * 64 + jch] + hc) * gelu_fast(bf1(grL[tau * 64 + jch])); } }
                }
            }
            if (MODE == 1) {
                __syncthreads();
                float o[16];
#pragma unroll
                for (int q = 0; q < 4; ++q) { const f32x4 hv = *(const LAS f32x4*)(xcf + ctok * 68 + 16 * ccg + 4 * q); o[4 * q] = hv.x; o[4 * q + 1] = hv.y; o[4 * q + 2] = hv.z; o[4 * q + 3] = hv.w; }
                bf16_t* op = AO + (rowbase + t0 + ctok) * DM + 512 + ch0;
                *(bf16x8*)op = pack8(o); *(bf16x8*)(op + 8) = pack8(o + 8);
            }
        }
#undef LOAD_INPUTS
    }
}

constexpr size_t WS_HS = WS_HF;
constexpr size_t WS_XC = WS_IDX;
template <int PH>
__device__ __forceinline__ void lru_sweep(const Args& a, LAS unsigned char* lds) {
    const int tid = threadIdx.x, lane = tid & 63, wid = __builtin_amdgcn_readfirstlane(tid >> 6), r32 = lane & 31, hi = lane >> 5;
    const bf16_t* QKV = (const bf16_t*)(a.ws + WS_QKV);
    bf16_t* AO = (bf16_t*)(a.ws + WS_AO);
    float* HS = (float*)(a.ws + WS_HS);
    float* XC = (float*)(a.ws + WS_XC);
    const u32x4* LW = (const u32x4*)(a.ws + WS_LW);
    LAS float* xcf = (LAS float*)lds;
    LAS u32x4* wL = (LAS u32x4*)(lds + 34816);
    LAS bf16_t* grL = (LAS bf16_t*)(lds + 67584);
    LAS float* wtA = (LAS float*)(lds + 83968);
    LAS float* wtB = (LAS float*)(lds + 86016);
    LAS float* cwL = (LAS float*)(lds + 88064);
    LAS float* carry = (LAS float*)(lds + 89344);
    const int tt = wid & 3, ct = wid >> 2;
    const int ctok = tid >> 2, ccg = tid & 3;
    const int jch = ct * 32 + r32;
    for (int v = blockIdx.x; v < 256; v += gridDim.x) {
        const int n = v & 7, b = v >> 4, half = (v >> 3) & 1;
        const int dir = (PH == 0) ? half : 1 - half;
        const int ch0 = n * 64 + 16 * ccg;
        __syncthreads();
        if (tid < 320) { const int r = tid >> 6, c = tid & 63; cwL[tid] = (r < 4) ? a.in[I_CONVW][r * 512 + n * 64 + c] : a.in[I_CONVB][n * 64 + c]; }
        for (int i = tid; i < 1024; i += NTHREADS) wL[i] = LW[(size_t)((dir * 8 + n) * 1024) + i];
        if (tid < 64) carry[tid] = (PH == 0) ? 0.f : XC[((size_t)((b * 8 + n) * 2 + dir)) * 64 + tid];
        const int chj = n * 64 + jch;
        const float nr = -a.in[I_LBR][dir * 512 + chj] * LOG2E, ni = -a.in[I_LBI][dir * 512 + chj] * LOG2E;
        const float lam = a.in[I_LAM][dir * 512 + chj];
        const float cc8 = -8.0f * ((lam > 15.f) ? __expf(-lam) : log1pf(__expf(-lam)));
        __syncthreads();
        const int NT = (PH == 0) ? 18 : 16;
        u32x4 xin[4][2], gin[2];
#define SW_TILE(S_, ISCTX, TILE) const bool ISCTX = (PH == 0) && (S_) < 2; \
            const int TILE = (PH == 0) ? (ISCTX ? (dir ? 1 - (S_) : (S_)) : (dir ? 33 - (S_) : (S_) - 2)) : (dir ? 15 - (S_) : 16 + (S_))
#define SW_LOAD(S_) do { SW_TILE(S_, isctx_, tile_); const int LS_ = isctx_ ? LCTX : SEQL; \
            const size_t rowbase_ = isctx_ ? ((size_t)ML + b * LCTX) : ((size_t)b * SEQL); const int tok_ = tile_ * 128 + ctok; \
            _Pragma("unroll") for (int j = 0; j < 4; ++j) { const int tj = tok_ + j - 2; \
                if (tj >= 0 && tj < LS_) { const bf16_t* xp = QKV + (rowbase_ + tj) * NIN + 768 + ch0; xin[j][0] = *(const u32x4*)xp; xin[j][1] = *(const u32x4*)(xp + 8); } \
                else { xin[j][0] = (u32x4){0u, 0u, 0u, 0u}; xin[j][1] = (u32x4){0u, 0u, 0u, 0u}; } } \
            if (PH == 1) { const bf16_t* gp = QKV + (rowbase_ + tok_) * NIN + 1280 + ch0; gin[0] = *(const u32x4*)gp; gin[1] = *(const u32x4*)(gp + 8); } } while (0)
        SW_LOAD(0);
        for (int st = 0; st < NT; ++st) {
            SW_TILE(st, isctx, tile);
            const size_t rowbase = isctx ? ((size_t)ML + b * LCTX) : ((size_t)b * SEQL);
            const int t0 = tile * 128;
            {
                float acc[16];
#pragma unroll
                for (int q = 0; q < 4; ++q) { const f32x4 bv = *(const LAS f32x4*)(cwL + 4 * 64 + 16 * ccg + 4 * q); acc[4 * q] = bv.x; acc[4 * q + 1] = bv.y; acc[4 * q + 2] = bv.z; acc[4 * q + 3] = bv.w; }
#pragma unroll
                for (int j = 0; j < 4; ++j) { float xv[16]; unpack8(xin[j][0], xv); unpack8(xin[j][1], xv + 8);
#pragma unroll
                    for (int q = 0; q < 4; ++q) { const f32x4 wv = *(const LAS f32x4*)(cwL + j * 64 + 16 * ccg + 4 * q);
                        acc[4 * q] += wv.x * xv[4 * q]; acc[4 * q + 1] += wv.y * xv[4 * q + 1]; acc[4 * q + 2] += wv.z * xv[4 * q + 2]; acc[4 * q + 3] += wv.w * xv[4 * q + 3]; } }
#pragma unroll
                for (int q = 0; q < 4; ++q) *(LAS f32x4*)(xcf + ctok * 68 + 16 * ccg + 4 * q) = (f32x4){acc[4 * q], acc[4 * q + 1], acc[4 * q + 2], acc[4 * q + 3]};
                if (PH == 1) { *(LAS u32x4*)(grL + ctok * 64 + 16 * ccg) = gin[0]; *(LAS u32x4*)(grL + ctok * 64 + 16 * ccg + 8) = gin[1]; }
            }
            if (st + 1 < NT) SW_LOAD(st + 1);
            __syncthreads();
            float av[16], bv[16];
            {
                f32x16 accR = f32x16{}, accI = f32x16{};
#pragma unroll
                for (int s = 0; s < 4; ++s) { const LAS float* xp = xcf + (tt * 32 + r32) * 68 + 16 * s + 8 * hi; const f32x4 p0 = *(const LAS f32x4*)xp, p1 = *(const LAS f32x4*)(xp + 4);
                    float t8[8] = {p0.x, p0.y, p0.z, p0.w, p1.x, p1.y, p1.z, p1.w}; const bf16x8 af = pack8(t8);
                    const bf16x8 wrf = __builtin_bit_cast(bf16x8, wL[((0 * 2 + ct) * 4 + s) * 64 + lane]), wif = __builtin_bit_cast(bf16x8, wL[((1 * 2 + ct) * 4 + s) * 64 + lane]);
                    accR = __builtin_amdgcn_mfma_f32_32x32x16_bf16(af, wrf, accR, 0, 0, 0); accI = __builtin_amdgcn_mfma_f32_32x32x16_bf16(af, wif, accI, 0, 0, 0); }
#define LRU_GATE_LOOP(FALLBACK) _Pragma("unroll") for (int r = 0; r < 16; ++r) { const int tau = tt * 32 + crow(r, hi); \
                    const float rg = __builtin_amdgcn_rcpf(1.0f + __builtin_amdgcn_exp2f(__builtin_fmaf(accR[r], -LOG2E, nr))), ig = __builtin_amdgcn_rcpf(1.0f + __builtin_amdgcn_exp2f(__builtin_fmaf(accI[r], -LOG2E, ni))), xv = xcf[tau * 68 + jch]; \
                    const float log_a = cc8 * rg; av[r] = __builtin_amdgcn_exp2f(log_a * LOG2E); \
                    const float x2 = 2.0f * log_a; \
                    float om = -x2 * (1.0f + x2 * (0.5f + x2 * (0.16666667f + x2 * (0.041666668f + x2 * 0.008333334f)))); \
                    if (FALLBACK) { if (x2 <= -0.25f) om = 1.0f - __builtin_amdgcn_exp2f(x2 * LOG2E); } \
                    bv[r] = __builtin_amdgcn_sqrtf(om) * ig * xv; }
                if (__builtin_expect(__any(-2.0f * cc8 >= 0.25f), 0)) { LRU_GATE_LOOP(true) } else { LRU_GATE_LOOP(false) }
#undef LRU_GATE_LOOP
            }
            float hs[16];
            if (PH == 1) {
#pragma unroll
                for (int r = 0; r < 16; ++r) hs[r] = HS[(rowbase + t0 + tt * 32 + crow(r, hi)) * 512 + chj];
            }
#define SW_SCAN(DIR_) do { \
            float QA[8], QB[8]; \
            { \
                float qa[4], qb[4]; \
            _Pragma("unroll") \
                for (int g = 0; g < 4; ++g) { float A = 1.f, Bq = 0.f; \
            _Pragma("unroll") \
                    for (int ee = 0; ee < 4; ++ee) { const int r = 4 * g + (DIR_ ? 3 - ee : ee); Bq = av[r] * Bq + bv[r]; A *= av[r]; } \
                    qa[g] = A; qb[g] = Bq; } \
            _Pragma("unroll") \
                for (int g = 0; g < 4; ++g) { const float pa = __shfl_xor(qa[g], 32), pb = __shfl_xor(qb[g], 32); \
                    QA[2 * g] = hi ? pa : qa[g]; QA[2 * g + 1] = hi ? qa[g] : pa; QB[2 * g] = hi ? pb : qb[g]; QB[2 * g + 1] = hi ? qb[g] : pb; } \
            } \
            { \
                float AW = 1.f, BW = 0.f; \
            _Pragma("unroll") \
                for (int qq = 0; qq < 8; ++qq) { const int q = DIR_ ? 7 - qq : qq; BW = QA[q] * BW + QB[q]; AW *= QA[q]; } \
                if (hi == 0) { wtA[tt * 64 + jch] = AW; wtB[tt * 64 + jch] = BW; } \
            } \
            __syncthreads(); \
            { \
                float h = carry[(st & 1) * 64 + jch]; \
            _Pragma("unroll") \
                for (int ww = 0; ww < 4; ++ww) { const int w = DIR_ ? 3 - ww : ww; const float sa = wtA[w * 64 + jch], sb = wtB[w * 64 + jch]; \
                    if (DIR_ ? (w > tt) : (w < tt)) h = sa * h + sb; } \
                float hin[4] = {0.f, 0.f, 0.f, 0.f}; \
            _Pragma("unroll") \
                for (int qq = 0; qq < 8; ++qq) { const int q = DIR_ ? 7 - qq : qq; hin[q >> 1] = ((q & 1) == hi) ? h : hin[q >> 1]; h = QA[q] * h + QB[q]; } \
                if (tt == (DIR_ ? 0 : 3) && hi == 0) { \
                    carry[((st + 1) & 1) * 64 + jch] = h; \
                    if (PH == 0 && st == NT - 1) XC[((size_t)((b * 8 + n) * 2 + dir)) * 64 + jch] = h; \
                } \
                if (!isctx) { \
            _Pragma("unroll") \
                    for (int g = 0; g < 4; ++g) { float hc = hin[g]; \
            _Pragma("unroll") \
                        for (int ee = 0; ee < 4; ++ee) { const int r = 4 * g + (DIR_ ? 3 - ee : ee); hc = av[r] * hc + bv[r]; \
                            const int tau = tt * 32 + crow(r, hi); \
                            if (PH == 0) HS[(rowbase + t0 + tau) * 512 + chj] = hc; \
                            else xcf[tau * 68 + jch] = (hs[r] + hc) * gelu_fast(bf1(grL[tau * 64 + jch])); } } \
                } \
            } \
            } while (0)
            if (dir) SW_SCAN(1); else SW_SCAN(0);
#undef SW_SCAN
            if (PH == 1) {
                __syncthreads();
                float o[16];
#pragma unroll
                for (int q = 0; q < 4; ++q) { const f32x4 hv = *(const LAS f32x4*)(xcf + ctok * 68 + 16 * ccg + 4 * q); o[4 * q] = hv.x; o[4 * q + 1] = hv.y; o[4 * q + 2] = hv.z; o[4 * q + 3] = hv.w; }
                bf16_t* op = AO + (rowbase + t0 + ctok) * DM + 512 + ch0;
                *(bf16x8*)op = pack8(o); *(bf16x8*)(op + 8) = pack8(o + 8);
            }
        }
#undef SW_TILE
#undef SW_LOAD
    }
}

__device__ __forceinline__ void phase3a(const Args& a, LAS unsigned char* lds) {
    lru_sweep<0>(a, lds);
    unsigned* ctr = (unsigned*)(a.ws + WS_CTL) + 64;
    LAS int* slot = (LAS int*)(lds + 140000);
#pragma unroll 1
    for (int gg = 0; gg < 8; ++gg) {
        const int g = ((int)(blockIdx.x & 7) + gg) & 7;
        unsigned* qc = ctr + 256 + 64 * g;
        for (;;) {
            __syncthreads();
            if (threadIdx.x == 0) *slot = (int)atomicAdd(qc, 1u);
            __syncthreads();
            const int li = *slot;
            if (li >= 128) break;
#ifndef NO_ATTN
            attn_unit(a, lds, (g * 4 + (li >> 5)) * 32 + (li & 31));
#endif
        }
    }
    if (gridDim.x == 256) {
        constexpr int QN = (N_ITEMS_ALL - N_DEFER - N_ITEMS_P0) / 16;
        static_assert((N_ITEMS_ALL - N_DEFER - N_ITEMS_P0) % 16 == 0, "weight-copy queue granularity");
        const int lane = threadIdx.x & 63, wid = threadIdx.x >> 6;
        LAS float* scr = (LAS float*)(lds + wid * 16896);
        for (;;) {
            __syncthreads();
            if (threadIdx.x == 0) *slot = (int)atomicAdd(ctr + 128, 1u);
            __syncthreads();
            const int g = *slot;
            if (g >= QN) break;
            const int it0 = N_ITEMS_P0 + g * 16 + wid * 2;
            const TItem t0 = decode_item(a, a.ws, it0); const TItem t1 = decode_item(a, a.ws, it0 + 1);
            transpose_pair(t0, t1, true, scr, lane);
        }
    }
}
__device__ __forceinline__ void phase3b(const Args& a, LAS unsigned char* lds) {
    lru_sweep<1>(a, lds);
}

__device__ __forceinline__ void phase5(const Args& a, LAS unsigned char* lds) {
    const int tid = threadIdx.x, lane = tid & 63, wid = __builtin_amdgcn_readfirstlane(tid >> 6);
    LAS u32x4* WH = (LAS u32x4*)lds;
    LAS u32x4* WLo = (LAS u32x4*)(lds + 32768);
    LAS float* cL = (LAS float*)(lds + 65536);
    const float* mod = (const float*)(a.ws + WS_MOD); bf16_t* H2 = (bf16_t*)(a.ws + WS_H); float* aff = (float*)(a.ws + WS_AFF);
    const float* wr = a.in[I_WROUTER];
    for (int blk = blockIdx.x; blk < ML / 256; blk += gridDim.x) {
        const int b = blk >> 4, row0 = blk * 256;
        const float* sh2 = mod + b * 6144 + 3072; const float* sc2 = mod + b * 6144 + 4096;
        __syncthreads();
        for (int idx = tid; idx < 2048; idx += NTHREADS) {
            const int e = idx & 15, kq = (idx >> 4) & 3, ks = idx >> 6, k0 = 32 * ks + 8 * kq;
            float w[8], wl[8];
#pragma unroll
            for (int j = 0; j < 8; ++j) { const int d = k0 + j; w[j] = a.in[I_N2G][d] * (1.0f + sc2[d]) * wr[d * 16 + e]; }
            u32x4 hi; hi.x = pk2(w[0], w[1]); hi.y = pk2(w[2], w[3]); hi.z = pk2(w[4], w[5]); hi.w = pk2(w[6], w[7]);
            float wh[8]; unpack8(hi, wh);
#pragma unroll
            for (int j = 0; j < 8; ++j) wl[j] = w[j] - wh[j];
            u32x4 lo; lo.x = pk2(wl[0], wl[1]); lo.y = pk2(wl[2], wl[3]); lo.z = pk2(wl[4], wl[5]); lo.w = pk2(wl[6], wl[7]);
            WH[idx] = hi; WLo[idx] = lo;
        }
        if (wid == 0) {
            float ce[16];
#pragma unroll
            for (int e = 0; e < 16; ++e) ce[e] = 0.f;
            for (int i = 0; i < 16; ++i) { const int d = lane + 64 * i; const float sv = sh2[d];
#pragma unroll
                for (int e = 0; e < 16; ++e) ce[e] += sv * wr[d * 16 + e]; }
#pragma unroll
            for (int e = 0; e < 16; ++e) { const float t = wave_sum(ce[e]); if (lane == e) cL[e] = t; }
        }
        f32x4 gs[4], shv[4];
#pragma unroll
        for (int j = 0; j < 4; ++j) { const f32x4 g = *((const f32x4*)a.in[I_N2G] + lane + 64 * j), sc = *((const f32x4*)sc2 + lane + 64 * j); gs[j] = g * (sc + 1.0f); shv[j] = *((const f32x4*)sh2 + lane + 64 * j); }
        __syncthreads();
        const float cmine = cL[lane & 15];
        for (int it = 0; it < 2; ++it) {
            const int r0 = row0 + (wid * 2 + it) * 16;
            const float* xp = a.out + (size_t)(r0 + (lane & 15)) * DM + 8 * (lane >> 4);
            f32x4 acc = (f32x4){0.f, 0.f, 0.f, 0.f}; float ssq = 0.f;
#pragma unroll 1
            for (int kb = 0; kb < 4; ++kb) {
                f32x4 v[8][2];
#pragma unroll
                for (int i = 0; i < 8; ++i) { v[i][0] = *(const f32x4*)(xp + 32 * (kb * 8 + i)); v[i][1] = *(const f32x4*)(xp + 32 * (kb * 8 + i) + 4); }
#pragma unroll
                for (int i = 0; i < 8; ++i) {
                    const int ks = kb * 8 + i;
                    const float x[8] = {v[i][0].x, v[i][0].y, v[i][0].z, v[i][0].w, v[i][1].x, v[i][1].y, v[i][1].z, v[i][1].w};
#pragma unroll
                    for (int j = 0; j < 8; ++j) ssq += x[j] * x[j];
                    u32x4 hi; hi.x = pk2(x[0], x[1]); hi.y = pk2(x[2], x[3]); hi.z = pk2(x[4], x[5]); hi.w = pk2(x[6], x[7]);
                    float xh[8], xl[8]; unpack8(hi, xh);
#pragma unroll
                    for (int j = 0; j < 8; ++j) xl[j] = x[j] - xh[j];
                    u32x4 lo; lo.x = pk2(xl[0], xl[1]); lo.y = pk2(xl[2], xl[3]); lo.z = pk2(xl[4], xl[5]); lo.w = pk2(xl[6], xl[7]);
                    const bf16x8 ah = __builtin_bit_cast(bf16x8, hi), al = __builtin_bit_cast(bf16x8, lo);
                    const bf16x8 bh = __builtin_bit_cast(bf16x8, WH[ks * 64 + lane]), bl = __builtin_bit_cast(bf16x8, WLo[ks * 64 + lane]);
                    acc = __builtin_amdgcn_mfma_f32_16x16x32_bf16(ah, bh, acc, 0, 0, 0);
                    acc = __builtin_amdgcn_mfma_f32_16x16x32_bf16(al, bh, acc, 0, 0, 0);
                    acc = __builtin_amdgcn_mfma_f32_16x16x32_bf16(ah, bl, acc, 0, 0, 0);
                }
            }
            ssq += __shfl_xor(ssq, 16); ssq += __shfl_xor(ssq, 32);
            const float rstd_l = rsqrtf(ssq * (1.0f / DM) + EPSN);
#pragma unroll
            for (int rg = 0; rg < 4; ++rg) {
                const int row = 4 * (lane >> 4) + rg;
                const float rs = __shfl(rstd_l, row);
                const float lg = acc[rg] * rs + cmine;
                float mx = lg; mx = fmaxf(mx, __shfl_xor(mx, 1)); mx = fmaxf(mx, __shfl_xor(mx, 2)); mx = fmaxf(mx, __shfl_xor(mx, 4)); mx = fmaxf(mx, __shfl_xor(mx, 8));
                const float ex = expf(lg - mx);
                float sm = ex; sm += __shfl_xor(sm, 1); sm += __shfl_xor(sm, 2); sm += __shfl_xor(sm, 4); sm += __shfl_xor(sm, 8);
                const int t = (r0 + row) & 4095;
                aff[((size_t)(b * 16 + (lane & 15))) * SEQL + t] = ex / sm;
            }
#pragma unroll 1
            for (int rr = 0; rr < 16; rr += 4) {
                f32x4 hv[4][4];
#pragma unroll
                for (int q = 0; q < 4; ++q) load_row(a.out + (size_t)(r0 + rr + q) * DM, lane, hv[q]);
#pragma unroll
                for (int q = 0; q < 4; ++q) { const float rs = __shfl(rstd_l, rr + q);
#pragma unroll
                    for (int j = 0; j < 4; ++j) { const f32x4 o = (hv[q][j] * rs) * gs[j] + shv[j]; u32x2 w2; w2.x = pk2(o.x, o.y); w2.y = pk2(o.z, o.w); *((u32x2*)(H2 + (size_t)(r0 + rr + q) * DM) + lane + 64 * j) = w2; } }
            }
        }
    }
}

__device__ __forceinline__ void phase6(const Args& a, LAS unsigned char* lds) {
    const int tid = threadIdx.x, lane = tid & 63, wid = tid >> 6;
    LAS unsigned* hist = (LAS unsigned*)lds;
    LAS unsigned* selw = (LAS unsigned*)(lds + 1024);
    LAS unsigned* wtot = (LAS unsigned*)(lds + 1088);
    LAS int* selL = (LAS int*)(lds + 2048);
    const float* aff = (const float*)(a.ws + WS_AFF); const bf16_t* H2 = (const bf16_t*)(a.ws + WS_H);
    int* idx = (int*)(a.ws + WS_IDX); float* gv = (float*)(a.ws + WS_GV); bf16_t* XS = (bf16_t*)(a.ws + WS_XS); int* slotOf = (int*)(a.ws + WS_SLOT);
    for (int item = blockIdx.x; item < NB * NE; item += gridDim.x) {
        const int b = item >> 4;
        const float* ap = aff + (size_t)item * SEQL + tid * 8;
        const f32x4 f0 = *(const f32x4*)ap, f1 = *(const f32x4*)(ap + 4);
        const float fv[8] = {f0.x, f0.y, f0.z, f0.w, f1.x, f1.y, f1.z, f1.w};
        unsigned u[8];
#pragma unroll
        for (int i = 0; i < 8; ++i) u[i] = __builtin_bit_cast(unsigned, fv[i]);
        unsigned prefix = 0, mask = 0, remaining = CAP;
        for (int pass = 0; pass < 4; ++pass) {
            const int shift = 24 - 8 * pass;
            if (tid < 256) hist[tid] = 0;
            __syncthreads();
#pragma unroll
            for (int i = 0; i < 8; ++i) if ((u[i] & mask) == prefix) atomicAdd((unsigned*)&hist[(u[i] >> shift) & 255], 1u);
            __syncthreads();
            if (wid == 0) {
                unsigned c4[4]; unsigned s = 0;
#pragma unroll
                for (int j = 0; j < 4; ++j) { c4[j] = hist[255 - (4 * lane + j)]; s += c4[j]; }
                unsigned incl = s;
#pragma unroll
                for (int o = 1; o < 64; o <<= 1) { const unsigned t = __shfl_up(incl, o); if (lane >= o) incl += t; }
                const unsigned excl = incl - s;
                if (excl < remaining && remaining <= incl) {
                    unsigned run = excl; int jb = 0; unsigned rem = 0; bool found = false;
#pragma unroll
                    for (int j = 0; j < 4; ++j) { if (!found && run + c4[j] >= remaining) { jb = j; rem = remaining - run; found = true; } if (!found) run += c4[j]; }
                    selw[0] = 255 - (4 * lane + jb); selw[1] = rem;
                }
            }
            __syncthreads();
            prefix |= selw[0] << shift; mask |= 255u << shift; remaining = selw[1];
            __syncthreads();
        }
        const unsigned T = prefix;
        unsigned cg_ = 0, ce = 0;
#pragma unroll
        for (int i = 0; i < 8; ++i) { cg_ += (u[i] > T); ce += (u[i] == T); }
        const unsigned packed = cg_ | (ce << 16);
        unsigned incl = packed;
#pragma unroll
        for (int o = 1; o < 64; o <<= 1) { const unsigned t = __shfl_up(incl, o); if (lane >= o) incl += t; }
        if (lane == 63) wtot[wid] = incl;
        __syncthreads();
        unsigned base = 0;
        for (int w = 0; w < wid; ++w) base += wtot[w];
        const unsigned excl = base + incl - packed;
        unsigned gB = excl & 0xffffu, eB = excl >> 16;
#pragma unroll
        for (int i = 0; i < 8; ++i) {
            const int t = tid * 8 + i; int pos = -1;
            if (u[i] > T) { pos = (int)(gB + (eB < remaining ? eB : remaining)); ++gB; }
            else if (u[i] == T) { if (eB < remaining) pos = (int)(gB + eB); ++eB; }
            if (pos >= 0) { idx[(size_t)item * CAP + pos] = b * SEQL + t; gv[(size_t)item * CAP + pos] = fv[i]; }
            slotOf[(size_t)item * SEQL + t] = pos;
        }
        __syncthreads();
        __syncthreads();
    }
}

__device__ __forceinline__ void phase9(const Args& a) {
    const int lane = threadIdx.x & 63, wid = threadIdx.x >> 6;
    const int gw = blockIdx.x * NWAVES + wid, NGW = gridDim.x * NWAVES;
    const float* mod = (const float*)(a.ws + WS_MOD); const bf16_t* YS = (const bf16_t*)(a.ws + WS_YS); const int* slotOf = (const int*)(a.ws + WS_SLOT);
    int pn = -1;
    if (gw < ML && lane < 16) pn = slotOf[((size_t)((gw >> 12) * 16 + lane)) * SEQL + (gw & 4095)];
    for (int m = gw; m < ML; m += NGW) {
        const int b = m >> 12;
        const int myp = pn; pn = -1;
        { const int mn = m + NGW; if (mn < ML && lane < 16) pn = slotOf[((size_t)((mn >> 12) * 16 + lane)) * SEQL + (mn & 4095)]; }
        float* op = a.out + (size_t)m * DM + 8 * lane; const float* g2 = mod + b * 6144 + 5120 + 8 * lane;
        f32x4 xv[2][2], gg[2][2];
#pragma unroll
        for (int j = 0; j < 2; ++j)
#pragma unroll
            for (int q = 0; q < 2; ++q) { xv[j][q] = *(const f32x4*)(op + 512 * j + 4 * q); gg[j][q] = *(const f32x4*)(g2 + 512 * j + 4 * q); }
        float acc[2][8];
#pragma unroll
        for (int j = 0; j < 2; ++j)
#pragma unroll
            for (int i = 0; i < 8; ++i) acc[j][i] = 0.f;
        unsigned long long msk = __ballot(myp >= 0);
        while (msk) {
            const int e0 = __builtin_ctzll(msk); msk &= msk - 1;
            const bool two = msk != 0; const int e1 = two ? __builtin_ctzll(msk) : e0; if (two) msk &= msk - 1;
            const int p0 = __shfl(myp, e0), p1 = __shfl(myp, e1);
            const bf16_t* y0 = YS + ((size_t)(b * 16 + e0) * CAP + p0) * DM + 8 * lane; const bf16_t* y1 = YS + ((size_t)(b * 16 + e1) * CAP + p1) * DM + 8 * lane;
            const u32x4 r00 = *(const u32x4*)y0, r01 = *(const u32x4*)(y0 + 512), r10 = *(const u32x4*)y1, r11 = *(const u32x4*)(y1 + 512);
            const float w1 = two ? 1.f : 0.f;
            float t0[8], t1[8];
            unpack8(r00, t0); unpack8(r10, t1);
#pragma unroll
            for (int i = 0; i < 8; ++i) acc[0][i] += t0[i] + w1 * t1[i];
            unpack8(r01, t0); unpack8(r11, t1);
#pragma unroll
            for (int i = 0; i < 8; ++i) acc[1][i] += t0[i] + w1 * t1[i];
        }
#pragma unroll
        for (int j = 0; j < 2; ++j)
#pragma unroll
            for (int q = 0; q < 2; ++q) { const f32x4 av = (f32x4){acc[j][4 * q], acc[j][4 * q + 1], acc[j][4 * q + 2], acc[j][4 * q + 3]};
                *(f32x4*)(op + 512 * j + 4 * q) = xv[j][q] + gg[j][q] * av; }
    }
}


#define XB_TMO      128
#define XB_XCNT(j)  (256  + 64 * (j))
#define XB_XSUB(j)  (1280 + 64 * (j))
#define XB_XGEN(j)  (2304 + 64 * (j))
#define XB_TOP      3328
#define XB_TOPGEN   3392
#define XCD_BAR_WORDS 3456
#define XB_SPIN_CAP (1u << 18)
__device__ __forceinline__ unsigned xb_ld(unsigned* p)              { return __hip_atomic_load(p, __ATOMIC_RELAXED, __HIP_MEMORY_SCOPE_AGENT); }
__device__ __forceinline__ unsigned xb_add(unsigned* p, unsigned v) { return __hip_atomic_fetch_add(p, v, __ATOMIC_RELAXED, __HIP_MEMORY_SCOPE_AGENT); }
__device__ __forceinline__ unsigned xb_xcc_id() { return (unsigned)__builtin_amdgcn_s_getreg((3 << 11) | 20) & 0xFu; }
#define XB_SPIN(cond, bar) do { unsigned _sp = 0; while (cond) { __builtin_amdgcn_s_sleep(1); \
    if ((++_sp & 255u) == 0u) { if (xb_ld(&(bar)[XB_TMO])) break; if (_sp > XB_SPIN_CAP) { atomicAdd(&(bar)[XB_TMO], 1u); break; } } } } while (0)
struct XcdBarrier { unsigned* bar; unsigned x; volatile LAS unsigned* st; };
__device__ __forceinline__ XcdBarrier xcd_barrier_post(unsigned* bar, volatile LAS unsigned* st) {
    XcdBarrier b; b.bar = bar; b.x = xb_xcc_id(); b.st = st;
    if (threadIdx.x == 0) (void)xb_add(&bar[XB_XCNT(b.x)], 1u);
    return b;
}
__device__ __forceinline__ void xcd_barrier_complete(unsigned* bar, unsigned x, unsigned& nloc, unsigned& nx) {
    const unsigned G = gridDim.x * gridDim.y * gridDim.z;
    unsigned sum, cnt, mine, sp = 0u;
    for (;;) {
        sum = 0u; cnt = 0u; mine = 0u;
#pragma unroll
        for (unsigned j = 0; j < 16; ++j) { const unsigned c = xb_ld(&bar[XB_XCNT(j)]); sum += c; cnt += (c > 0u) ? 1u : 0u; mine = (j == x) ? c : mine; }
        if (sum == G) break;
        __builtin_amdgcn_s_sleep(1);
        if ((++sp & 255u) == 0u) { if (xb_ld(&bar[XB_TMO])) break; if (sp > XB_SPIN_CAP) { atomicAdd(&bar[XB_TMO], 1u); break; } }
    }
    nloc = mine > 0u ? mine : 1u; nx = cnt > 0u ? cnt : 1u;
}
__device__ __forceinline__ void xcd_barrier(const XcdBarrier& b) {
    asm volatile("s_waitcnt vmcnt(0)" ::: "memory");
    __syncthreads();
    if (threadIdx.x == 0) {
        unsigned* bar = b.bar;
        __builtin_amdgcn_s_waitcnt(0);
        unsigned nloc = b.st[0], nx = b.st[1];
        if (nloc == 0u) { xcd_barrier_complete(bar, b.x, nloc, nx); b.st[0] = nloc; b.st[1] = nx; }
        const unsigned old = xb_add(&bar[XB_XSUB(b.x)], 1u);
        const unsigned gen = old / nloc;
        if (old + 1u == (gen + 1u) * nloc) {
            __builtin_amdgcn_fence(__ATOMIC_RELEASE, "agent");
            asm volatile("s_waitcnt vmcnt(0)" ::: "memory");
            const unsigned og = xb_add(&bar[XB_TOP], 1u);
            const unsigned tg = og / nx;
            if (og + 1u == (tg + 1u) * nx) xb_add(&bar[XB_TOPGEN], 1u);
            else XB_SPIN(xb_ld(&bar[XB_TOPGEN]) == tg, bar);
            __builtin_amdgcn_fence(__ATOMIC_ACQUIRE, "agent");
            xb_add(&bar[XB_XGEN(b.x)], 1u);
            asm volatile("s_waitcnt vmcnt(0)" ::: "memory");
        } else {
            XB_SPIN(xb_ld(&bar[XB_XGEN(b.x)]) == gen, bar);
            __builtin_amdgcn_fence(__ATOMIC_ACQUIRE, "agent");
            asm volatile("s_waitcnt vmcnt(0)" ::: "memory");
        }
    }
    __syncthreads();
}

constexpr int NPHASE = 10;
__global__ void __launch_bounds__(NTHREADS, 2) fwd_kernel(Args args) {
    extern __shared__ __attribute__((aligned(16))) unsigned char lds_raw[];
    LAS unsigned char* lds = (LAS unsigned char*)lds_raw;
    cg::grid_group grid = cg::this_grid();
    const int lo = args.ph_lo, hi = args.ph_hi;
    unsigned char* ws = args.ws;
#ifdef ONLY_PHASE
#define IN(k) ((k)==ONLY_PHASE && lo <= (k) && (k) < hi)
#else
#define IN(k) (lo <= (k) && (k) < hi)
#endif
    { LAS unsigned* st0 = (LAS unsigned*)(lds + 147328); if (threadIdx.x < 2) st0[threadIdx.x] = 0u; __syncthreads(); }
    const XcdBarrier xbar = xcd_barrier_post((unsigned*)(ws + WS_CTL) + 4096, (volatile LAS unsigned*)(lds + 147328));
    if (args.ph_hi < 0) grid.sync();
#define SEAM(k) do { if (IN(k) && IN((k) + 1)) xcd_barrier(xbar); } while (0)
#ifndef REPEAT_MASK
#define REPEAT_MASK 0
#endif
#define REP(k, body) do { if ((REPEAT_MASK >> (k)) & 1) { grid.sync(); body; } } while (0)
    if (IN(0)) { phase0(args, lds); REP(0, phase0(args, lds)); } SEAM(0);
    if (IN(1)) { phase1(args); REP(1, phase1(args)); } SEAM(1);
    if (IN(2)) {
        pg8::Gemm g{(const bf16_t*)(ws + WS_H), (const bf16_t*)(ws + WS_WIN), MT, NIN, DM, nullptr}; pg8::Order S; S.init(MT, NIN, gridDim.x, blockIdx.x, 0, 0);
        pg8::EpiStoreBf16 E{(bf16_t*)(ws + WS_QKV), NIN, nullptr};
        pg8::gemm_phase<pg8::EpiStoreBf16>(lds, g, S, E);
        deferred_weight_copies(args, lds);
    } SEAM(2);
    if (IN(3)) { phase3a(args, lds); xcd_barrier(xbar); phase3b(args, lds); } SEAM(3);
    if (IN(4)) {
        pg8::Gemm g{(const bf16_t*)(ws + WS_AO), (const bf16_t*)(ws + WS_WOUT), ML, DM, DM, nullptr}; pg8::Order S; S.init(ML, DM, gridDim.x, blockIdx.x, 0, 0);
        pg8::EpiResid E{args.in[I_X], args.out, (const float*)(ws + WS_MOD) + 2048};
        pg8::gemm_phase<pg8::EpiResid>(lds, g, S, E);
        REP(4, pg8::gemm_phase<pg8::EpiResid>(lds, g, S, E));
    } SEAM(4);
    if (IN(5)) { phase5(args, lds); REP(5, phase5(args, lds)); } SEAM(5);
    if (IN(6)) { phase6(args, lds); REP(6, phase6(args, lds)); } SEAM(6);
    if (IN(7)) {
        pg8::Gemm g{(const bf16_t*)(ws + WS_H), (const bf16_t*)(ws + WS_WUP), MX, 2048, DM, (const int*)(ws + WS_IDX)};   pg8::Order S; S.init(MX, 2048, gridDim.x, blockIdx.x, 1, (size_t)2048 * DM * 2);
        pg8::EpiSwiGLU E{(bf16_t*)(ws + WS_HID)};
        pg8::gemm_phase<pg8::EpiSwiGLU, true, true>(lds, g, S, E);
    } SEAM(7);
    if (IN(8)) {
        pg8::Gemm g{(const bf16_t*)(ws + WS_HID), (const bf16_t*)(ws + WS_WDN), MX, DM, DM, nullptr}; pg8::Order S; S.init(MX, DM, gridDim.x, blockIdx.x, 1, (size_t)DM * DM * 2);
        pg8::EpiStoreBf16 E{(bf16_t*)(ws + WS_YS), DM, (const float*)(ws + WS_GV)};
        pg8::gemm_phase<pg8::EpiStoreBf16>(lds, g, S, E);
        REP(8, pg8::gemm_phase<pg8::EpiStoreBf16>(lds, g, S, E));
    } SEAM(8);
    if (IN(9)) { phase9(args); }
#undef IN
#undef SEAM
}

#ifndef MK_PER_PHASE
#define MK_PER_PHASE 0
#endif
extern "C" void kernel_launch(void* const* d_in, const int* in_sizes, int n_in, void* d_out, int out_size, void* d_ws, size_t ws_size, hipStream_t stream) {
    static int grid = 0;
    if (grid == 0) {
        if (n_in != 24 || out_size != ML * DM || ws_size < WS_END) { fprintf(stderr, "kernel_launch: unexpected shapes (n_in %d out %d ws %zu)\n", n_in, out_size, ws_size); grid = -1; return; }
        int dev = 0, cus = 0, per_cu = 0;
        hipGetDevice(&dev); hipDeviceGetAttribute(&cus, hipDeviceAttributeMultiprocessorCount, dev);
        if (hipFuncSetAttribute((const void*)fwd_kernel, hipFuncAttributeMaxDynamicSharedMemorySize, LDS_BYTES) != hipSuccess) { fprintf(stderr, "kernel_launch: hipFuncSetAttribute failed\n"); grid = -1; return; }
        hipOccupancyMaxActiveBlocksPerMultiprocessor(&per_cu, (const void*)fwd_kernel, NTHREADS, LDS_BYTES);
        (void)hipGetLastError();
        if (per_cu < 1) per_cu = 1;
        grid = cus;
        fprintf(stderr, "kernel_launch: grid %d (occupancy query %d/CU)\n", grid, per_cu);
    }
    if (grid < 0) return;
    hipMemsetAsync((char*)d_ws + WS_CTL, 0, 65536, stream);
    Args a{};
    for (int i = 0; i < 24; ++i) a.in[i] = (const float*)d_in[i];
    a.out = (float*)d_out; a.ws = (unsigned char*)d_ws;
#if MK_PER_PHASE
    for (int p = 0; p < NPHASE; ++p) {
        a.ph_lo = p; a.ph_hi = p + 1;
        void* kargs[] = {&a};
        hipError_t e = hipLaunchCooperativeKernel((const void*)fwd_kernel, dim3(grid), dim3(NTHREADS), kargs, LDS_BYTES, stream);
        if (e != hipSuccess) { fprintf(stderr, "kernel_launch: launch of phase %d failed: %s\n", p, hipGetErrorString(e)); break; }
    }
#else
    a.ph_lo = 0; a.ph_hi = NPHASE;
    void* kargs[] = {&a};
    hipError_t e = hipLaunchCooperativeKernel((const void*)fwd_kernel, dim3(grid), dim3(NTHREADS), kargs, LDS_BYTES, stream);
    if (e != hipSuccess) fprintf(stderr, "kernel_launch: cooperative launch failed: %s (grid %d)\n", hipGetErrorString(e), grid);
#endif
}
```
